# Optimizing an MI355X kernel written in HIP

```python
import math
import jax, jax.numpy as jnp
from jax import lax
import numpy as np

D_MODEL = 1024
BATCH = 4
SEQ = 8192
DEPTH = 1

N_META = 16
MIX_WIDTH = D_MODEL
DIFF_WIDTH = MIX_WIDTH // 2
WIN_WIDTH = MIX_WIDTH - DIFF_WIDTH
DIFF_HEAD_DIM = 64
DIFF_HEADS = DIFF_WIDTH // (2 * DIFF_HEAD_DIM)
WIN_HEAD_DIM = 64
WIN_HEADS = WIN_WIDTH // WIN_HEAD_DIM
WIN_KV_HEADS = 2
WIN_GROUP = WIN_HEADS // WIN_KV_HEADS
WINDOW = 128
BLOCK = 128
D_FF = ((8 * D_MODEL // 3 + 127) // 128) * 128
ROPE_THETA = 10000.0
EPS = 1e-6
NEG = -1e30

A_Q = DIFF_HEADS * 2 * DIFF_HEAD_DIM
A_K = DIFF_HEADS * 2 * DIFF_HEAD_DIM
A_V = DIFF_HEADS * 2 * DIFF_HEAD_DIM
B_Q = WIN_HEADS * WIN_HEAD_DIM
B_K = WIN_KV_HEADS * WIN_HEAD_DIM
B_V = WIN_KV_HEADS * WIN_HEAD_DIM
IN_WIDTH = A_Q + A_K + A_V + B_Q + B_K + B_V

kernel_name = "hymba_diff_window_macaron_encoder"


def rmsnorm(x, g):
    xf = x.astype(jnp.float32)
    y = xf * lax.rsqrt(jnp.mean(xf * xf, axis=-1, keepdims=True) + EPS)
    return (y * g.astype(jnp.float32)).astype(x.dtype)


def swiglu(x, w_gate, w_up, w_down):
    return (jax.nn.silu(x @ w_gate) * (x @ w_up)) @ w_down


def rope_tables(length, dim):
    pos = jnp.arange(length, dtype=jnp.float32)
    inv = ROPE_THETA ** (-jnp.arange(0, dim, 2, dtype=jnp.float32) / dim)
    ang = pos[:, None] * inv[None, :]
    return jnp.cos(ang), jnp.sin(ang)


def apply_rope(x, cos, sin):
    shape = (cos.shape[0],) + (1,) * (x.ndim - 3) + (cos.shape[1],)
    c = cos.reshape(shape).astype(x.dtype)
    s = sin.reshape(shape).astype(x.dtype)
    half = x.shape[-1] // 2
    x1, x2 = x[..., :half], x[..., half:]
    return jnp.concatenate([x1 * c - x2 * s, x2 * c + x1 * s], axis=-1)


def diff_attention(q, k, v, lam, sub_gain, lambda_init):
    b_, l_ = q.shape[0], q.shape[1]
    scale = DIFF_HEAD_DIM ** -0.5

    def attend(qb):
        s = jnp.einsum('bqhcd,bkhcd->bhcqk', qb, k, preferred_element_type=jnp.float32) * scale
        p = jax.nn.softmax(s, axis=-1)
        a = p[:, :, 0] - lam * p[:, :, 1]
        return jnp.einsum('bhqk,bkhe->bqhe', a.astype(v.dtype), v)

    out_meta = attend(q[:, :N_META])
    nb = (l_ - N_META) // BLOCK
    qr = q[:, N_META:].reshape(b_, nb, BLOCK, DIFF_HEADS, 2, DIFF_HEAD_DIM).transpose(1, 0, 2, 3, 4, 5)
    out_real = lax.map(attend, qr)
    out_real = out_real.transpose(1, 0, 2, 3, 4).reshape(b_, nb * BLOCK, DIFF_HEADS, 2 * DIFF_HEAD_DIM)
    o = jnp.concatenate([out_meta, out_real], axis=1)
    o = rmsnorm(o, sub_gain) * (1.0 - lambda_init)
    return o.reshape(b_, l_, DIFF_WIDTH)


def window_attention(q, k, v, sink):
    b_, l_ = q.shape[0], q.shape[1]
    s_len = l_ - N_META
    nb = s_len // BLOCK
    scale = WIN_HEAD_DIM ** -0.5
    sink_f = sink.astype(jnp.float32)[:, :, None, None]

    def softmax_with_sink(s):
        sk = jnp.broadcast_to(sink_f, s.shape[:-1] + (1,))
        return jax.nn.softmax(jnp.concatenate([s, sk], axis=-1), axis=-1)[..., :-1]

    s_m = jnp.einsum('bqhgd,bkhd->bhgqk', q[:, :N_META], k, preferred_element_type=jnp.float32) * scale
    o_m = jnp.einsum('bhgqk,bkhd->bqhgd', softmax_with_sink(s_m).astype(v.dtype), v)

    km, vm = k[:, :N_META], v[:, :N_META]
    qr = q[:, N_META:].reshape(b_, nb, BLOCK, WIN_KV_HEADS, WIN_GROUP, WIN_HEAD_DIM)

    def neighbours(t):
        tb = t.reshape(b_, nb, BLOCK, WIN_KV_HEADS, WIN_HEAD_DIM)
        tp = jnp.pad(tb, ((0, 0), (1, 1), (0, 0), (0, 0), (0, 0)))
        return jnp.concatenate([tp[:, :-2], tp[:, 1:-1], tp[:, 2:]], axis=2)

    kr = neighbours(k[:, N_META:])
    vr = neighbours(v[:, N_META:])
    s_meta = jnp.einsum('bnqhgd,bkhd->bnhgqk', qr, km, preferred_element_type=jnp.float32) * scale
    s_band = jnp.einsum('bnqhgd,bnkhd->bnhgqk', qr, kr, preferred_element_type=jnp.float32) * scale
    qi = jnp.arange(BLOCK)[:, None]
    kj = jnp.arange(3 * BLOCK)[None, :] - BLOCK
    kabs = jnp.arange(nb)[:, None, None] * BLOCK + kj[None]
    valid = (jnp.abs(kj - qi)[None] <= WINDOW) & (kabs >= 0) & (kabs < s_len)
    s_band = jnp.where(valid[None, :, None, None], s_band, NEG)
    p = softmax_with_sink(jnp.concatenate([s_meta, s_band], axis=-1)).astype(v.dtype)
    o_r = (jnp.einsum('bnhgqk,bkhd->bnqhgd', p[..., :N_META], vm)
           + jnp.einsum('bnhgqk,bnkhd->bnqhgd', p[..., N_META:], vr))
    o_r = o_r.reshape(b_, s_len, WIN_KV_HEADS, WIN_GROUP, WIN_HEAD_DIM)
    o = jnp.concatenate([o_m, o_r], axis=1)
    return o.reshape(b_, l_, WIN_WIDTH)


def setup_inputs(seed: int = 0) -> dict:
    key = jax.random.key(seed)
    ks = jax.random.split(key, 24)
    f32 = jnp.float32

    def nrm(k, shape, scale):
        return jax.random.normal(k, shape, f32) * scale

    def gain(k, shape):
        return 1.0 + 0.02 * jax.random.normal(k, shape, f32)

    return {
        "x": nrm(ks[0], (BATCH, SEQ, D_MODEL), 1.0),
        "meta_tokens": nrm(ks[1], (N_META, D_MODEL), 1.0),
        "ffn1_norm": gain(ks[2], (DEPTH, D_MODEL)),
        "ffn1_w_gate": nrm(ks[3], (DEPTH, D_MODEL, D_FF), D_MODEL ** -0.5),
        "ffn1_w_up": nrm(ks[4], (DEPTH, D_MODEL, D_FF), D_MODEL ** -0.5),
        "ffn1_w_down": nrm(ks[5], (DEPTH, D_FF, D_MODEL), D_FF ** -0.5),
        "mix_norm": gain(ks[6], (DEPTH, D_MODEL)),
        "w_in": nrm(ks[7], (DEPTH, D_MODEL, IN_WIDTH), D_MODEL ** -0.5),
        "lambda_q1": nrm(ks[8], (DEPTH, DIFF_HEAD_DIM), 0.1),
        "lambda_k1": nrm(ks[9], (DEPTH, DIFF_HEAD_DIM), 0.1),
        "lambda_q2": nrm(ks[10], (DEPTH, DIFF_HEAD_DIM), 0.1),
        "lambda_k2": nrm(ks[11], (DEPTH, DIFF_HEAD_DIM), 0.1),
        "diff_norm": gain(ks[12], (DEPTH, 2 * DIFF_HEAD_DIM)),
        "win_sink": nrm(ks[13], (DEPTH, WIN_HEADS), 0.5),
        "win_norm": gain(ks[14], (DEPTH, WIN_WIDTH)),
        "w_out": nrm(ks[15], (DEPTH, MIX_WIDTH, D_MODEL), MIX_WIDTH ** -0.5),
        "ffn2_norm": gain(ks[16], (DEPTH, D_MODEL)),
        "ffn2_w_gate": nrm(ks[17], (DEPTH, D_MODEL, D_FF), D_MODEL ** -0.5),
        "ffn2_w_up": nrm(ks[18], (DEPTH, D_MODEL, D_FF), D_MODEL ** -0.5),
        "ffn2_w_down": nrm(ks[19], (DEPTH, D_FF, D_MODEL), D_FF ** -0.5),
        "final_norm": gain(ks[20], (D_MODEL,)),
    }


def reference(x, meta_tokens, ffn1_norm, ffn1_w_gate, ffn1_w_up, ffn1_w_down, mix_norm, w_in,
              lambda_q1, lambda_k1, lambda_q2, lambda_k2, diff_norm, win_sink, win_norm, w_out,
              ffn2_norm, ffn2_w_gate, ffn2_w_up, ffn2_w_down, final_norm):
    b_ = x.shape[0]
    meta = jnp.broadcast_to(meta_tokens.astype(x.dtype)[None], (b_, N_META, D_MODEL))
    h = jnp.concatenate([meta, x], axis=1)
    l_ = h.shape[1]
    cos, sin = rope_tables(l_, DIFF_HEAD_DIM)

    for l in range(DEPTH):
        h = h + 0.5 * swiglu(rmsnorm(h, ffn1_norm[l]), ffn1_w_gate[l], ffn1_w_up[l], ffn1_w_down[l])

        u = rmsnorm(h, mix_norm[l])
        z = u @ w_in[l]
        o0 = 0
        qa = z[..., o0:o0 + A_Q].reshape(b_, l_, DIFF_HEADS, 2, DIFF_HEAD_DIM); o0 += A_Q
        ka = z[..., o0:o0 + A_K].reshape(b_, l_, DIFF_HEADS, 2, DIFF_HEAD_DIM); o0 += A_K
        va = z[..., o0:o0 + A_V].reshape(b_, l_, DIFF_HEADS, 2 * DIFF_HEAD_DIM); o0 += A_V
        qb = z[..., o0:o0 + B_Q].reshape(b_, l_, WIN_KV_HEADS, WIN_GROUP, WIN_HEAD_DIM); o0 += B_Q
        kb = z[..., o0:o0 + B_K].reshape(b_, l_, WIN_KV_HEADS, WIN_HEAD_DIM); o0 += B_K
        vb = z[..., o0:o0 + B_V].reshape(b_, l_, WIN_KV_HEADS, WIN_HEAD_DIM)

        qa = apply_rope(qa, cos, sin)
        ka = apply_rope(ka, cos, sin)
        lambda_init = 0.8 - 0.6 * math.exp(-0.3 * l)
        lam = (jnp.exp(jnp.sum(lambda_q1[l].astype(jnp.float32) * lambda_k1[l].astype(jnp.float32)))
               - jnp.exp(jnp.sum(lambda_q2[l].astype(jnp.float32) * lambda_k2[l].astype(jnp.float32)))
               + lambda_init)
        out_a = diff_attention(qa, ka, va, lam, diff_norm[l], lambda_init)

        qb = apply_rope(qb, cos, sin)
        kb = apply_rope(kb, cos, sin)
        out_b = window_attention(qb, kb, vb, win_sink[l].reshape(WIN_KV_HEADS, WIN_GROUP))
        out_b = rmsnorm(out_b, win_norm[l])

        h = h + jnp.concatenate([out_a, out_b], axis=-1) @ w_out[l]

        h = h + 0.5 * swiglu(rmsnorm(h, ffn2_norm[l]), ffn2_w_gate[l], ffn2_w_up[l], ffn2_w_down[l])

    h = rmsnorm(h, final_norm)
    return h[:, N_META:]
```

```cpp
#include <hip/hip_runtime.h>
#include <hip/hip_cooperative_groups.h>
#include <hip/hip_bf16.h>
#include <cstdio>
#include <cstdint>
namespace cg = cooperative_groups;
#ifndef MK_ONE_LAUNCH
#define MK_ONE_LAUNCH 1
#endif
namespace pg8 {
#define PG8_LAS __attribute__((address_space(3)))
typedef unsigned short bf16_t;
typedef short bf16x8 __attribute__((ext_vector_type(8)));
typedef float f32x4 __attribute__((ext_vector_type(4)));
typedef unsigned u32x4 __attribute__((ext_vector_type(4)));
constexpr int BM = 256, BK = 64, HALF = 128, HTB = HALF * BK * 2  , STAGE_BYTES = 8 * HTB, NXCD = 8, WGM = 8;

__host__ __device__ __forceinline__ int lds_byte(int r, int c) { const int st = (r >> 4) * 2 + (c >> 5), rr = r & 15, cc = c & 31, ob = rr * 64 + cc * 2; return st * 1024 + (ob ^ (((ob >> 9) & 1) << 5)); }
__host__ __device__ __forceinline__ void stage_rc(int b, int& R, int& C) { const int st = b / 1024, sb = b % 1024, swz = sb ^ (((sb >> 9) & 1) << 5); R = (st >> 1) * 16 + swz / 64; C = (st & 1) * 32 + (swz % 64) / 2; }
__host__ __device__ __forceinline__ int perm32(int rho) { const int n = rho >> 4, i = rho & 15; return 8 * (i >> 2) + 4 * n + (i & 3); }

struct Unit { int pm, pn; };
struct Gemm { const bf16_t* A; const bf16_t* Bt; int M, N, K; };

struct StaticOrder {
    int nM, nN, nwg, G, c;
    __host__ __device__ void init(int M, int N, int G_, int c_) { nM = M / BM; nN = N / BM; nwg = nM * nN; G = G_; c = c_; }
    __host__ __device__ bool next(int i, Unit& u) const {
        const long L = (long)i * G + c; if (L >= nwg) return false;
        int wgid = (int)L; { const int q = nwg / NXCD, r = nwg % NXCD, xcd = wgid % NXCD, off = wgid / NXCD; wgid = (xcd < r ? xcd * (q + 1) : r * (q + 1) + (xcd - r) * q) + off; }
        const int nig = WGM * nN, gid = wgid / nig, fm = gid * WGM, gsz = (nM - fm) < WGM ? (nM - fm) : WGM;
        u.pm = fm + ((wgid % nig) % gsz); u.pn = (wgid % nig) / gsz; return true;
    }
    __device__ __forceinline__ void a_ready(const Unit&) const {}
    __device__ __forceinline__ void done(const Unit&) const {}
};

__device__ __forceinline__ unsigned cvt_pk_bf16(float lo, float hi) { unsigned r; asm volatile("v_cvt_pk_bf16_f32 %0, %1, %2" : "=v"(r) : "v"(lo), "v"(hi)); return r; }
typedef float f32x2 __attribute__((ext_vector_type(2)));
constexpr float RMS_EPS = 1e-6f;
__device__ __forceinline__ float rstd1024(float ss) { return __builtin_amdgcn_rsqf(ss * (1.0f / 1024.0f) + RMS_EPS); }
__device__ __forceinline__ float silu_mul(float g, float u) { return g * __builtin_amdgcn_rcpf(1.0f + __builtin_amdgcn_exp2f(-1.4426950408889634f * g)) * u; }

__device__ __forceinline__ float fmul_s(float a, float b) { float r; asm volatile("v_mul_f32_e32 %0, %1, %2" : "=v"(r) : "v"(a), "v"(b)); return r; }
__device__ __forceinline__ float ffma_s(float a, float b, float c) { float r; asm volatile("v_fma_f32 %0, %1, %2, %3" : "=v"(r) : "v"(a), "v"(b), "v"(c)); return r; }
struct EpiSwiGLU {
    static constexpr bool PERM = true, AFTER_DRAIN = false;
    bf16_t* H; int ldh; const float* ss;
    __device__ __forceinline__ void operator()(const f32x4 (&acc)[2][2][4][2], const Unit& u, int wr, int wc, int fr, int fq) const {
        const int row0 = u.pm * BM + wr * 64 + fr; const int col0 = u.pn * HALF + wc * 32 + 8 * fq;
        float v8[8];
#pragma unroll
        for (int i = 0; i < 8; ++i) v8[i] = ss[row0 + (i >> 2) * HALF + (i & 3) * 16];
#pragma unroll
        for (int ai = 0; ai < 2; ++ai)
#pragma unroll
            for (int m = 0; m < 4; ++m) { const int row = row0 + ai * HALF + m * 16; const float v = v8[ai * 4 + m] * (1.0f / 1024.0f) + RMS_EPS;
                const float rs = __builtin_amdgcn_rsqf(v); const float a = rs * -1.4426950408889634f;
                float h[8];
#pragma unroll
                for (int n = 0; n < 2; ++n)
#pragma unroll
                    for (int e = 0; e < 4; ++e) { const float g = acc[ai][0][m][n][e], uu = acc[ai][1][m][n][e];
                        const float ex = __builtin_amdgcn_exp2f(g * a); const float r = __builtin_amdgcn_rcpf(__builtin_fmaf(ex, v, v)); h[n * 4 + e] = (g * uu) * r; }
                u32x4 w; w.x = cvt_pk_bf16(h[0], h[1]); w.y = cvt_pk_bf16(h[2], h[3]); w.z = cvt_pk_bf16(h[4], h[5]); w.w = cvt_pk_bf16(h[6], h[7]);
                *(u32x4*)(H + (size_t)row * ldh + col0) = w; }
    }
};
typedef unsigned u32x2 __attribute__((ext_vector_type(2)));
template <bool WB> struct EpiResid {
    static constexpr bool PERM = true, AFTER_DRAIN = false;
    const float* base; float* out; bf16_t* outb; float* ssout; float alpha; int ldc;
    __device__ __forceinline__ void operator()(const f32x4 (&acc)[2][2][4][2], const Unit& u, int wr, int wc, int fr, int fq) const {
        const int row0 = u.pm * BM + wr * 64 + fr; const int col0 = u.pn * BM + wc * 32 + 8 * fq;
#pragma unroll
        for (int ai = 0; ai < 2; ++ai)
#pragma unroll
            for (int m = 0; m < 4; ++m) { const int row = row0 + ai * HALF + m * 16; const size_t off = (size_t)row * ldc + col0; float q = 0.f;
#pragma unroll
                for (int bj = 0; bj < 2; ++bj) { const f32x4 b0 = *(const f32x4*)(base + off + bj * HALF), b1 = *(const f32x4*)(base + off + bj * HALF + 4);
                    const f32x4 o0 = b0 + acc[ai][bj][m][0] * alpha, o1 = b1 + acc[ai][bj][m][1] * alpha;
                    *(f32x4*)(out + off + bj * HALF) = o0; *(f32x4*)(out + off + bj * HALF + 4) = o1;
                    q += (o0[0] * o0[0] + o0[1] * o0[1]) + (o0[2] * o0[2] + o0[3] * o0[3]) + (o1[0] * o1[0] + o1[1] * o1[1]) + (o1[2] * o1[2] + o1[3] * o1[3]);
                    if (WB) { u32x4 w; w.x = cvt_pk_bf16(o0[0], o0[1]); w.y = cvt_pk_bf16(o0[2], o0[3]); w.z = cvt_pk_bf16(o1[0], o1[1]); w.w = cvt_pk_bf16(o1[2], o1[3]); *(u32x4*)(outb + off + bj * HALF) = w; } }
                q += __shfl_xor(q, 16); q += __shfl_xor(q, 32);
                if (fq == 0) __hip_atomic_fetch_add(ssout + row, q, __ATOMIC_RELAXED, __HIP_MEMORY_SCOPE_AGENT); }
    }
};
constexpr float QK_C2 = 0.125f * 1.4426950408889634f;
struct EpiQKV {
    static constexpr bool PERM = true, AFTER_DRAIN = false;
    bf16_t *QA, *KA, *VA, *QBW, *KB, *VB; const float* ss; const float* rope;
    __device__ __forceinline__ void operator()(const f32x4 (&acc)[2][2][4][2], const Unit& u, int wr, int wc, int fr, int fq) const {
        const int t = u.pn, hl = wc, i0 = 8 * fq; const int row0 = u.pm * BM + wr * 64 + fr;
        bf16_t* dst; int ld, col; bool do_rope, kv; float sc = 1.f;
        if (t < 2) { dst = QA; ld = 512; col = (t * 4 + hl) * 64; do_rope = true; kv = false; sc = QK_C2; }
        else if (t < 4) { dst = KA; ld = 512; col = ((t - 2) * 4 + hl) * 64; do_rope = true; kv = true; }
        else if (t < 6) { dst = VA; ld = 512; col = (t - 4) * 256 + hl * 64; do_rope = false; kv = true; }
        else if (t < 8) { dst = QBW; ld = 512; col = ((t - 6) * 4 + hl) * 64; do_rope = true; kv = false; sc = QK_C2; }
        else if (hl < 2) { dst = KB; ld = 128; col = hl * 64; do_rope = true; kv = true; }
        else { dst = VB; ld = 128; col = (hl - 2) * 64; do_rope = false; kv = true; }
        float rs8[8];
#pragma unroll
        for (int i = 0; i < 8; ++i) rs8[i] = ss[row0 + (i >> 2) * HALF + (i & 3) * 16];
#pragma unroll
        for (int ai = 0; ai < 2; ++ai)
#pragma unroll
            for (int m = 0; m < 4; ++m) { const int row = row0 + ai * HALF + m * 16; const int b = row >> 13, s = row & 8191; const float rs = rstd1024(rs8[ai * 4 + m]);
                const size_t drow = kv ? (size_t)b * 8256 + s : (size_t)row;
                f32x4 x1a = acc[ai][0][m][0] * rs, x1b = acc[ai][0][m][1] * rs, x2a = acc[ai][1][m][0] * rs, x2b = acc[ai][1][m][1] * rs;
                if (do_rope) { const float* rp = rope + (size_t)(16 + s) * 64 + i0;
                    const f32x4 ca = *(const f32x4*)(rp), cb = *(const f32x4*)(rp + 4), sa = *(const f32x4*)(rp + 32), sb = *(const f32x4*)(rp + 36);
                    f32x4 o1a, o1b, o2a, o2b;
#pragma unroll
                    for (int e = 0; e < 4; ++e) {
                        const float cae = fmul_s(ca[e], sc), sae = fmul_s(sa[e], sc), cbe = fmul_s(cb[e], sc), sbe = fmul_s(sb[e], sc);
                        o1a[e] = ffma_s(x1a[e], cae, -fmul_s(x2a[e], sae)); o1b[e] = ffma_s(x1b[e], cbe, -fmul_s(x2b[e], sbe));
                        o2a[e] = ffma_s(x2a[e], cae, fmul_s(x1a[e], sae)); o2b[e] = ffma_s(x2b[e], cbe, fmul_s(x1b[e], sbe)); }
                    x1a = o1a; x1b = o1b; x2a = o2a; x2b = o2b; }
                u32x4 w1, w2; w1.x = cvt_pk_bf16(x1a[0], x1a[1]); w1.y = cvt_pk_bf16(x1a[2], x1a[3]); w1.z = cvt_pk_bf16(x1b[0], x1b[1]); w1.w = cvt_pk_bf16(x1b[2], x1b[3]);
                w2.x = cvt_pk_bf16(x2a[0], x2a[1]); w2.y = cvt_pk_bf16(x2a[2], x2a[3]); w2.z = cvt_pk_bf16(x2b[0], x2b[1]); w2.w = cvt_pk_bf16(x2b[2], x2b[3]);
                bf16_t* p = dst + drow * ld + col + i0; *(u32x4*)p = w1; *(u32x4*)(p + 32) = w2; }
    }
};

template <class Epi, class Sched, bool ALIGN_EPI = false, bool SP2 = false>
__device__ __forceinline__ void gemm_phase(PG8_LAS unsigned char* lds, const Gemm g, const Sched& S, const Epi& E, const int tid) {
    const int wid = __builtin_amdgcn_readfirstlane(tid >> 6), lane = tid & 63, wr = wid >> 2, wc = wid & 3, fr = lane & 15, fq = lane >> 4;
    const int K = g.K, nt = K / BK;
    unsigned voffA[2], voffB[2];
#pragma unroll
    for (int i = 0; i < 2; ++i) { int R, C; stage_rc(tid * 16 + i * 8192, R, C); const int Rb = Epi::PERM ? ((R & ~31) + perm32(R & 31)) : R;
        voffA[i] = (unsigned)(R * K + C) * 2u; voffB[i] = (unsigned)(Rb * K + C) * 2u; }
    const size_t kstep = (size_t)(BK * 2);
    const size_t hstep = (size_t)HALF * K * 2;
    const size_t tstep = 2 * hstep;
    const unsigned ldsw = (unsigned)wid * 1024u;
    const int aoff = lds_byte(wr * 64 + fr, fq * 8), boff = lds_byte(wc * 32 + fr, fq * 8);
#define PG8_SA(b, h) (((b) * 2 + (h)) * HTB)
#define PG8_SB(b, h) ((4 + (b) * 2 + (h)) * HTB)
#define PG8_STAGE(bufoff, gbase, voff) do { _Pragma("unroll") for (int _i = 0; _i < 2; ++_i) \
        __builtin_amdgcn_global_load_lds((const unsigned*)((const char*)(gbase) + (voff)[_i]), (PG8_LAS unsigned*)(lds + (bufoff) + ldsw + _i * 8192), 16, 0, 0); } while (0)
#define PG8_LDA(dst, b, h) do { _Pragma("unroll") for (int m = 0; m < 4; ++m) _Pragma("unroll") for (int k = 0; k < 2; ++k) dst[m][k] = *(const PG8_LAS bf16x8*)(lds + PG8_SA(b, h) + aoff + m * 2048 + k * 1024); } while (0)
#define PG8_LDB(dst, b, h) do { _Pragma("unroll") for (int n = 0; n < 2; ++n) _Pragma("unroll") for (int k = 0; k < 2; ++k) dst[n][k] = *(const PG8_LAS bf16x8*)(lds + PG8_SB(b, h) + boff + n * 2048 + k * 1024); } while (0)
#define PG8_MMA(ai, bj, At, Bt) do { __builtin_amdgcn_s_setprio(1); _Pragma("unroll") for (int m = 0; m < 4; ++m) _Pragma("unroll") for (int n = 0; n < 2; ++n) _Pragma("unroll") for (int k = 0; k < 2; ++k) \
        acc[ai][bj][m][n] = __builtin_amdgcn_mfma_f32_16x16x32_bf16(Bt[n][k], At[m][k], acc[ai][bj][m][n], 0, 0, 0); __builtin_amdgcn_s_setprio(0); } while (0)
#define PG8_WAIT_V(n) asm volatile("s_waitcnt vmcnt(" #n ")" ::: "memory")
#define PG8_WAIT_L(n) asm volatile("s_waitcnt lgkmcnt(" #n ")" ::: "memory")
#define PG8_BAR __builtin_amdgcn_s_barrier()
#define PG8_SCHED __builtin_amdgcn_sched_barrier(0)
    Unit cur, nxt; int ui = 0;
    if (!S.next(0, cur)) return;
    f32x4 acc[2][2][4][2];
#pragma unroll
    for (int a = 0; a < 2; ++a)
#pragma unroll
        for (int b = 0; b < 2; ++b)
#pragma unroll
            for (int m = 0; m < 4; ++m)
#pragma unroll
                for (int n = 0; n < 2; ++n) acc[a][b][m][n] = (f32x4){0.f, 0.f, 0.f, 0.f};
    bf16x8 At[4][2], B0[2][2], B1[2][2];
    const char* cA = (const char*)g.A + (size_t)cur.pm * tstep; const char* cB = (const char*)g.Bt + (size_t)cur.pn * tstep;
    S.a_ready(cur);
    if constexpr (SP2) {
        PG8_STAGE(PG8_SB(0, 0), cB, voffB); PG8_STAGE(PG8_SB(0, 1), cB + hstep, voffB); PG8_STAGE(PG8_SA(0, 0), cA, voffA); PG8_STAGE(PG8_SA(0, 1), cA + hstep, voffA);
        if (wr == 1) PG8_BAR;
        PG8_WAIT_V(2); PG8_BAR;
        PG8_STAGE(PG8_SB(1, 0), cB + kstep, voffB); PG8_STAGE(PG8_SA(1, 0), cA + kstep, voffA); PG8_STAGE(PG8_SB(1, 1), cB + hstep + kstep, voffB);
        PG8_WAIT_V(6); PG8_BAR;
    } else {
        PG8_STAGE(PG8_SB(0, 0), cB, voffB); PG8_STAGE(PG8_SA(0, 0), cA, voffA); PG8_STAGE(PG8_SB(0, 1), cB + hstep, voffB); PG8_STAGE(PG8_SA(0, 1), cA + hstep, voffA);
        if (wr == 1) PG8_BAR;
        PG8_WAIT_V(4); PG8_BAR;
        PG8_STAGE(PG8_SB(1, 0), cB + kstep, voffB); PG8_STAGE(PG8_SA(1, 0), cA + kstep, voffA); PG8_STAGE(PG8_SB(1, 1), cB + hstep + kstep, voffB);
        PG8_WAIT_V(6); PG8_BAR;
    }
    for (;;) {
        const bool has_next = S.next(ui + 1, nxt);
        const char* nA = has_next ? (const char*)g.A + (size_t)nxt.pm * tstep : cA; const char* nB = has_next ? (const char*)g.Bt + (size_t)nxt.pn * tstep : cB;
        for (int t = 0; t < nt; t += 2) {
            const bool last = (t == nt - 2);
            const char* a1 = cA + (size_t)(t + 1) * kstep;
            const char* a2 = last ? nA : cA + (size_t)(t + 2) * kstep; const char* b2 = last ? nB : cB + (size_t)(t + 2) * kstep;
            const char* a3 = a2 + kstep; const char* b3 = b2 + kstep;
            if (last && has_next) S.a_ready(nxt);
            if constexpr (SP2) {
            PG8_LDB(B0, 0, 0); PG8_LDB(B1, 0, 1); PG8_SCHED; PG8_LDA(At, 0, 0); PG8_STAGE(PG8_SA(1, 1), a1 + hstep, voffA);
            PG8_WAIT_V(8); PG8_WAIT_L(0); PG8_BAR; PG8_MMA(0, 0, At, B0); PG8_MMA(0, 1, At, B1); PG8_BAR; PG8_SCHED;
            PG8_LDA(At, 0, 1); PG8_STAGE(PG8_SB(0, 0), b2, voffB); PG8_STAGE(PG8_SB(0, 1), b2 + hstep, voffB); PG8_STAGE(PG8_SA(0, 0), a2, voffA);
            PG8_WAIT_V(8); PG8_WAIT_L(0); PG8_BAR; PG8_MMA(1, 0, At, B0); PG8_MMA(1, 1, At, B1); PG8_BAR; PG8_SCHED;
            PG8_LDB(B0, 1, 0); PG8_LDB(B1, 1, 1); PG8_SCHED; PG8_LDA(At, 1, 0); PG8_STAGE(PG8_SA(0, 1), a2 + hstep, voffA);
            PG8_WAIT_V(8); PG8_WAIT_L(0); PG8_BAR; PG8_MMA(0, 0, At, B0); PG8_MMA(0, 1, At, B1); PG8_BAR; PG8_SCHED;
            PG8_LDA(At, 1, 1); PG8_STAGE(PG8_SB(1, 0), b3, voffB); PG8_STAGE(PG8_SB(1, 1), b3 + hstep, voffB); PG8_STAGE(PG8_SA(1, 0), a3, voffA);
            PG8_WAIT_V(8); PG8_WAIT_L(0); PG8_BAR; PG8_MMA(1, 0, At, B0); PG8_MMA(1, 1, At, B1); PG8_BAR; PG8_SCHED;
            } else {
            PG8_LDB(B0, 0, 0); PG8_SCHED; PG8_LDA(At, 0, 0); PG8_STAGE(PG8_SA(1, 1), a1 + hstep, voffA);
            PG8_WAIT_L(8); PG8_BAR; PG8_WAIT_L(0); PG8_MMA(0, 0, At, B0); PG8_BAR; PG8_SCHED;
            PG8_LDB(B1, 0, 1); PG8_STAGE(PG8_SB(0, 0), b2, voffB);
            PG8_BAR; PG8_WAIT_L(0); PG8_MMA(0, 1, At, B1); PG8_BAR;
            PG8_LDA(At, 0, 1); PG8_STAGE(PG8_SA(0, 0), a2, voffA);
            PG8_BAR; PG8_WAIT_L(0); PG8_MMA(1, 0, At, B0); PG8_BAR; PG8_SCHED;
            PG8_STAGE(PG8_SB(0, 1), b2 + hstep, voffB);
            PG8_WAIT_V(6); PG8_BAR; PG8_MMA(1, 1, At, B1); PG8_BAR;
            PG8_LDB(B0, 1, 0); PG8_SCHED; PG8_LDA(At, 1, 0); PG8_STAGE(PG8_SA(0, 1), a2 + hstep, voffA);
            PG8_WAIT_L(8); PG8_BAR; PG8_WAIT_L(0); PG8_MMA(0, 0, At, B0); PG8_BAR; PG8_SCHED;
            PG8_LDB(B1, 1, 1); PG8_STAGE(PG8_SB(1, 0), b3, voffB);
            PG8_BAR; PG8_WAIT_L(0); PG8_MMA(0, 1, At, B1); PG8_BAR;
            PG8_LDA(At, 1, 1); PG8_STAGE(PG8_SA(1, 0), a3, voffA);
            PG8_BAR; PG8_WAIT_L(0); PG8_MMA(1, 0, At, B0); PG8_BAR; PG8_SCHED;
            PG8_STAGE(PG8_SB(1, 1), b3 + hstep, voffB);
            PG8_WAIT_V(6); PG8_BAR; PG8_MMA(1, 1, At, B1); PG8_BAR;
            }
        }
        if constexpr (ALIGN_EPI) { if (wr == 0) PG8_BAR; }
        if constexpr (!Epi::AFTER_DRAIN) { E(acc, cur, wr, wc, fr, fq); S.done(cur); }
        if (!has_next) break;
#pragma unroll
        for (int a = 0; a < 2; ++a)
#pragma unroll
            for (int b = 0; b < 2; ++b)
#pragma unroll
                for (int m = 0; m < 4; ++m)
#pragma unroll
                    for (int n = 0; n < 2; ++n) acc[a][b][m][n] = (f32x4){0.f, 0.f, 0.f, 0.f};
        cur = nxt; cA = nA; cB = nB; ++ui;
        if constexpr (ALIGN_EPI) { if (wr == 1) PG8_BAR; }
    }
    PG8_WAIT_V(0);
    if constexpr (!ALIGN_EPI) { if (wr == 0) PG8_BAR; }
    PG8_BAR;
    if constexpr (Epi::AFTER_DRAIN) { E.fused(acc, cur, wr, wc, fr, fq, lds, wid, lane); S.done(cur); }
#undef PG8_SA
#undef PG8_SB
#undef PG8_STAGE
#undef PG8_LDA
#undef PG8_LDB
#undef PG8_MMA
#undef PG8_WAIT_V
#undef PG8_WAIT_L
#undef PG8_BAR
#undef PG8_SCHED
}
}
namespace att {
#define ATT_LAS __attribute__((address_space(3)))
typedef unsigned short bf16_t;
typedef short bf16x8 __attribute__((ext_vector_type(8)));
typedef short s16x4 __attribute__((ext_vector_type(4)));
typedef float f32x16 __attribute__((ext_vector_type(16)));
typedef unsigned u32x4 __attribute__((ext_vector_type(4)));
typedef float f32x2_t __attribute__((ext_vector_type(2))); typedef __bf16 bf16x2_t __attribute__((ext_vector_type(2)));
#define SBAR() __builtin_amdgcn_sched_barrier(0)
__device__ __forceinline__ int crow(int r, int hi) { return (r & 3) + 8 * (r >> 2) + 4 * hi; }
__device__ __forceinline__ unsigned cvtpk_s(float lo, float hi) { f32x2_t v = {lo, hi}; bf16x2_t b = __builtin_convertvector(v, bf16x2_t); return __builtin_bit_cast(unsigned, b); }
__device__ __forceinline__ float bf_lo(unsigned w) { return __uint_as_float(w << 16); }
__device__ __forceinline__ float bf_hi(unsigned w) { return __uint_as_float(w & 0xffff0000u); }
typedef ATT_LAS const char* lds_cptr;
typedef ATT_LAS char* lds_ptr;
__device__ __forceinline__ void qkt(f32x16& p0, f32x16& p1, lds_cptr Kslot, const bf16x8* qr, int r32, int hi) {
    const f32x16 negm = {0.f,0.f,0.f,0.f,0.f,0.f,0.f,0.f,0.f,0.f,0.f,0.f,0.f,0.f,0.f,0.f};
    lds_cptr kb = Kslot + hi * 1024 + r32 * 16;
#pragma unroll
    for (int d0 = 0; d0 < 4; ++d0) {
        const bf16x8 b0 = *(const ATT_LAS bf16x8*)(kb + d0 * 2048);
        const bf16x8 b1 = *(const ATT_LAS bf16x8*)(kb + d0 * 2048 + 512);
        if (d0 == 0) { p0 = __builtin_amdgcn_mfma_f32_32x32x16_bf16(b0, qr[0], negm, 0, 0, 0); p1 = __builtin_amdgcn_mfma_f32_32x32x16_bf16(b1, qr[0], negm, 0, 0, 0); }
        else { p0 = __builtin_amdgcn_mfma_f32_32x32x16_bf16(b0, qr[d0], p0, 0, 0, 0); p1 = __builtin_amdgcn_mfma_f32_32x32x16_bf16(b1, qr[d0], p1, 0, 0, 0); } }
}
__device__ __forceinline__ float rowmax(const f32x16& p0, const f32x16& p1) {
    float a = __builtin_fmaxf(p0[0], p1[0]), b = __builtin_fmaxf(p0[1], p1[1]);
#pragma unroll
    for (int r = 2; r < 16; r += 2) { a = __builtin_fmaxf(a, __builtin_fmaxf(p0[r], p1[r])); b = __builtin_fmaxf(b, __builtin_fmaxf(p0[r + 1], p1[r + 1])); }
    const float m = __builtin_fmaxf(a, b);
    return __builtin_fmaxf(m, __shfl_xor(m, 32));
}
__device__ __forceinline__ float max3f(float a, float b, float c) { float r; asm("v_max3_f32 %0, %1, %2, %3" : "=v"(r) : "v"(a), "v"(b), "v"(c)); return r; }
__device__ __forceinline__ float max2f(float a, float b) { float r; asm("v_max_f32_e32 %0, %1, %2" : "=v"(r) : "v"(a), "v"(b)); return r; }
__device__ __forceinline__ float rowmax_fast(const f32x16& p0, const f32x16& p1) {
    float a = max3f(p0[0], p0[1], p1[0]), b = max3f(p0[2], p0[3], p1[1]); a = max3f(a, p1[2], p1[3]);
#pragma unroll
    for (int r = 4; r < 16; r += 4) { a = max3f(a, p0[r], p0[r + 1]); b = max3f(b, p0[r + 2], p0[r + 3]); a = max3f(a, p1[r], p1[r + 1]); b = max3f(b, p1[r + 2], p1[r + 3]); }
    const float m = max2f(a, b);
    auto rr = __builtin_amdgcn_permlane32_swap(__float_as_uint(m), __float_as_uint(m), false, false);
    return max2f(__uint_as_float(rr[0]), __uint_as_float(rr[1]));
}
template <int NDQ> __device__ __forceinline__ void pv(f32x16* o, int vb, bf16x8 pa0, bf16x8 pa1, bf16x8 pa2, bf16x8 pa3) {
#pragma unroll
    for (int d0 = 0; d0 < NDQ; ++d0) { s16x4 lo[4], hi[4];
#pragma unroll
        for (int ks = 0; ks < 4; ++ks) {
            asm volatile("ds_read_b64_tr_b16 %0,%1 offset:%c2" : "=&v"(lo[ks]) : "v"(vb), "i"(d0 * 4096 + ks * 1024) : "memory");
            asm volatile("ds_read_b64_tr_b16 %0,%1 offset:%c2" : "=&v"(hi[ks]) : "v"(vb), "i"(d0 * 4096 + ks * 1024 + 512) : "memory"); }
        asm volatile("s_waitcnt lgkmcnt(0)" ::: "memory"); SBAR();
#define ATT_PK(k) (bf16x8){lo[k][0], lo[k][1], lo[k][2], lo[k][3], hi[k][0], hi[k][1], hi[k][2], hi[k][3]}
        o[d0] = __builtin_amdgcn_mfma_f32_32x32x16_bf16(pa0, ATT_PK(0), o[d0], 0, 0, 0);
        o[d0] = __builtin_amdgcn_mfma_f32_32x32x16_bf16(pa1, ATT_PK(1), o[d0], 0, 0, 0);
        o[d0] = __builtin_amdgcn_mfma_f32_32x32x16_bf16(pa2, ATT_PK(2), o[d0], 0, 0, 0);
        o[d0] = __builtin_amdgcn_mfma_f32_32x32x16_bf16(pa3, ATT_PK(3), o[d0], 0, 0, 0);
#undef ATT_PK
    }
}
template <int NDQ> __device__ __forceinline__ void softmax_pv(f32x16& p0, f32x16& p1, float& mref, float& l, f32x16* o, int vb, int r32, ATT_LAS float* wsf, const ATT_LAS float* wsh) {
    const float rm = rowmax_fast(p0, p1) - mref;
    if (__any(rm > 8.0f)) {
        const float dl = __builtin_fmaxf(rm, 0.f); mref += dl;
        const float f = __builtin_amdgcn_exp2f(-dl); l *= f;
        wsf[r32] = f;
#pragma unroll
        for (int r = 0; r < 16; ++r) { const float fr_ = wsh[(r & 3) + 8 * (r >> 2)];
#pragma unroll
            for (int d = 0; d < NDQ; ++d) o[d][r] *= fr_; }
    }
    float s0 = 0.f, s1 = 0.f;
#pragma unroll
    for (int r = 0; r < 16; ++r) { p0[r] = __builtin_amdgcn_exp2f(p0[r] - mref); p1[r] = __builtin_amdgcn_exp2f(p1[r] - mref); s0 += p0[r]; s1 += p1[r]; }
    l += s0 + s1;
    u32x4 pw0, pw1, pw2, pw3;
    pw0 = (u32x4){cvtpk_s(p0[0], p0[1]), cvtpk_s(p0[2], p0[3]), cvtpk_s(p0[4], p0[5]), cvtpk_s(p0[6], p0[7])};
    pw1 = (u32x4){cvtpk_s(p0[8], p0[9]), cvtpk_s(p0[10], p0[11]), cvtpk_s(p0[12], p0[13]), cvtpk_s(p0[14], p0[15])};
    pw2 = (u32x4){cvtpk_s(p1[0], p1[1]), cvtpk_s(p1[2], p1[3]), cvtpk_s(p1[4], p1[5]), cvtpk_s(p1[6], p1[7])};
    pw3 = (u32x4){cvtpk_s(p1[8], p1[9]), cvtpk_s(p1[10], p1[11]), cvtpk_s(p1[12], p1[13]), cvtpk_s(p1[14], p1[15])};
    SBAR();
    pv<NDQ>(o, vb, __builtin_bit_cast(bf16x8, pw0), __builtin_bit_cast(bf16x8, pw1), __builtin_bit_cast(bf16x8, pw2), __builtin_bit_cast(bf16x8, pw3));
}
__device__ __forceinline__ f32x16 splat16(float v) { f32x16 x;
#pragma unroll
    for (int r = 0; r < 16; ++r) x[r] = v; return x; }
constexpr int KVROWS = 8256, NREAL = 8192, NKT = 129;
constexpr float NEG_INF = -__builtin_inff();

#ifndef ATT_NEGM
#define ATT_NEGM 0
#endif
#ifndef ATT_PVF
#define ATT_PVF pv2
#endif
template <int NDQ> __device__ __forceinline__ void pv2(f32x16* o, int vb, bf16x8 pa0, bf16x8 pa1, bf16x8 pa2, bf16x8 pa3) {
    s16x4 lo[2][4], hi[2][4];
#define ATT_RD(S, D) do { _Pragma("unroll") for (int ks = 0; ks < 4; ++ks) { \
        asm volatile("ds_read_b64_tr_b16 %0,%1 offset:%c2" : "=&v"(lo[S][ks]) : "v"(vb), "i"((D) * 4096 + ks * 1024) : "memory"); \
        asm volatile("ds_read_b64_tr_b16 %0,%1 offset:%c2" : "=&v"(hi[S][ks]) : "v"(vb), "i"((D) * 4096 + ks * 1024 + 512) : "memory"); } } while (0)
#define ATT_PK2(S, k) (bf16x8){lo[S][k][0], lo[S][k][1], lo[S][k][2], lo[S][k][3], hi[S][k][0], hi[S][k][1], hi[S][k][2], hi[S][k][3]}
    ATT_RD(0, 0);
#pragma unroll
    for (int d0 = 0; d0 < NDQ; ++d0) {
        if (d0 + 1 < NDQ) { if ((d0 & 1) == 0) ATT_RD(1, d0 + 1); else ATT_RD(0, d0 + 1); asm volatile("s_waitcnt lgkmcnt(8)" ::: "memory"); }
        else asm volatile("s_waitcnt lgkmcnt(0)" ::: "memory");
        SBAR();
        if ((d0 & 1) == 0) {
            o[d0] = __builtin_amdgcn_mfma_f32_32x32x16_bf16(pa0, ATT_PK2(0, 0), o[d0], 0, 0, 0); o[d0] = __builtin_amdgcn_mfma_f32_32x32x16_bf16(pa1, ATT_PK2(0, 1), o[d0], 0, 0, 0);
            o[d0] = __builtin_amdgcn_mfma_f32_32x32x16_bf16(pa2, ATT_PK2(0, 2), o[d0], 0, 0, 0); o[d0] = __builtin_amdgcn_mfma_f32_32x32x16_bf16(pa3, ATT_PK2(0, 3), o[d0], 0, 0, 0);
        } else {
            o[d0] = __builtin_amdgcn_mfma_f32_32x32x16_bf16(pa0, ATT_PK2(1, 0), o[d0], 0, 0, 0); o[d0] = __builtin_amdgcn_mfma_f32_32x32x16_bf16(pa1, ATT_PK2(1, 1), o[d0], 0, 0, 0);
            o[d0] = __builtin_amdgcn_mfma_f32_32x32x16_bf16(pa2, ATT_PK2(1, 2), o[d0], 0, 0, 0); o[d0] = __builtin_amdgcn_mfma_f32_32x32x16_bf16(pa3, ATT_PK2(1, 3), o[d0], 0, 0, 0);
        }
        SBAR();
    }
#undef ATT_RD
#undef ATT_PK2
}
struct VFrag { s16x4 lo[2][4], hi[2][4]; };
#define ATT_RDF(F, S, D) do { _Pragma("unroll") for (int ks = 0; ks < 4; ++ks) { \
        asm volatile("ds_read_b64_tr_b16 %0,%1 offset:%c2" : "=&v"(F.lo[S][ks]) : "v"(vb), "i"((D) * 4096 + ks * 1024) : "memory"); \
        asm volatile("ds_read_b64_tr_b16 %0,%1 offset:%c2" : "=&v"(F.hi[S][ks]) : "v"(vb), "i"((D) * 4096 + ks * 1024 + 512) : "memory"); } } while (0)
#define ATT_PKF(F, S, k) (bf16x8){F.lo[S][k][0], F.lo[S][k][1], F.lo[S][k][2], F.lo[S][k][3], F.hi[S][k][0], F.hi[S][k][1], F.hi[S][k][2], F.hi[S][k][3]}
__device__ __forceinline__ void pv4_issue0(VFrag& F, int vb) { ATT_RDF(F, 0, 0); }
__device__ __forceinline__ void pv4_rest(VFrag& F, f32x16* o, int vb, bf16x8 pa0, bf16x8 pa1, bf16x8 pa2, bf16x8 pa3) {
#pragma unroll
    for (int d0 = 0; d0 < 4; ++d0) {
        if (d0 + 1 < 4) { if ((d0 & 1) == 0) ATT_RDF(F, 1, d0 + 1); else ATT_RDF(F, 0, d0 + 1); asm volatile("s_waitcnt lgkmcnt(8)" ::: "memory"); }
        else asm volatile("s_waitcnt lgkmcnt(0)" ::: "memory");
        SBAR();
        if ((d0 & 1) == 0) {
            o[d0] = __builtin_amdgcn_mfma_f32_32x32x16_bf16(pa0, ATT_PKF(F, 0, 0), o[d0], 0, 0, 0); o[d0] = __builtin_amdgcn_mfma_f32_32x32x16_bf16(pa1, ATT_PKF(F, 0, 1), o[d0], 0, 0, 0);
            o[d0] = __builtin_amdgcn_mfma_f32_32x32x16_bf16(pa2, ATT_PKF(F, 0, 2), o[d0], 0, 0, 0); o[d0] = __builtin_amdgcn_mfma_f32_32x32x16_bf16(pa3, ATT_PKF(F, 0, 3), o[d0], 0, 0, 0);
        } else {
            o[d0] = __builtin_amdgcn_mfma_f32_32x32x16_bf16(pa0, ATT_PKF(F, 1, 0), o[d0], 0, 0, 0); o[d0] = __builtin_amdgcn_mfma_f32_32x32x16_bf16(pa1, ATT_PKF(F, 1, 1), o[d0], 0, 0, 0);
            o[d0] = __builtin_amdgcn_mfma_f32_32x32x16_bf16(pa2, ATT_PKF(F, 1, 2), o[d0], 0, 0, 0); o[d0] = __builtin_amdgcn_mfma_f32_32x32x16_bf16(pa3, ATT_PKF(F, 1, 3), o[d0], 0, 0, 0);
        }
        SBAR();
    }
}
__device__ __forceinline__ void qkt_c(f32x16& p0, f32x16& p1, lds_cptr Kslot, const bf16x8* qr, const f32x16& negm, int r32, int hi) {
    lds_cptr kb = Kslot + hi * 1024 + r32 * 16;
#pragma unroll
    for (int d0 = 0; d0 < 4; ++d0) {
        const bf16x8 b0 = *(const ATT_LAS bf16x8*)(kb + d0 * 2048);
        const bf16x8 b1 = *(const ATT_LAS bf16x8*)(kb + d0 * 2048 + 512);
        if (d0 == 0) { p0 = __builtin_amdgcn_mfma_f32_32x32x16_bf16(b0, qr[0], negm, 0, 0, 0); p1 = __builtin_amdgcn_mfma_f32_32x32x16_bf16(b1, qr[0], negm, 0, 0, 0); }
        else { p0 = __builtin_amdgcn_mfma_f32_32x32x16_bf16(b0, qr[d0], p0, 0, 0, 0); p1 = __builtin_amdgcn_mfma_f32_32x32x16_bf16(b1, qr[d0], p1, 0, 0, 0); } }
}
__device__ __forceinline__ void kload8(bf16x8* kf, lds_cptr kp) {
#pragma unroll
    for (int d0 = 0; d0 < 4; ++d0) { kf[2 * d0] = *(const ATT_LAS bf16x8*)(kp + d0 * 2048); kf[2 * d0 + 1] = *(const ATT_LAS bf16x8*)(kp + d0 * 2048 + 512); }
}
__device__ __forceinline__ void qk_held(f32x16& p0, f32x16& p1, const bf16x8* kf, const bf16x8* qr) {
    const f32x16 z = {0.f,0.f,0.f,0.f,0.f,0.f,0.f,0.f,0.f,0.f,0.f,0.f,0.f,0.f,0.f,0.f};
    p0 = __builtin_amdgcn_mfma_f32_32x32x16_bf16(kf[0], qr[0], z, 0, 0, 0); p1 = __builtin_amdgcn_mfma_f32_32x32x16_bf16(kf[1], qr[0], z, 0, 0, 0);
#pragma unroll
    for (int d0 = 1; d0 < 4; ++d0) { p0 = __builtin_amdgcn_mfma_f32_32x32x16_bf16(kf[2 * d0], qr[d0], p0, 0, 0, 0); p1 = __builtin_amdgcn_mfma_f32_32x32x16_bf16(kf[2 * d0 + 1], qr[d0], p1, 0, 0, 0); }
}
__device__ __forceinline__ void glds16(const void* gsrc, unsigned lds_dst) { unsigned keep;
    asm volatile("s_mov_b32 %0, m0\n\ts_mov_b32 m0, %2\n\ts_nop 0\n\tglobal_load_lds_dwordx4 %1, off\n\ts_mov_b32 m0, %0" : "=&s"(keep) : "v"(gsrc), "s"(lds_dst) : "memory"); }
__device__ __forceinline__ void diff_unit(int b, int h, int qb, const bf16_t* QA, const bf16_t* KA, const bf16_t* VA, bf16_t* ATT, float lam, lds_ptr lds, unsigned lds0, const int tid) {
    const int lane = tid & 63, r32 = lane & 31, hi = lane >> 5; const int wid = __builtin_amdgcn_readfirstlane(tid >> 6);
    const int grp = wid >> 2;
    const size_t m0 = (size_t)b * NREAL + (size_t)qb * 256 + wid * 32; const size_t kv0 = (size_t)b * KVROWS;
    const int vlane = ((lane >> 4) & 1) * 32 + (lane & 3) * 8 + (4 * hi + ((lane & 15) >> 2)) * 64;
    ATT_LAS float* wsf = (ATT_LAS float*)(lds + 131072 + wid * 256); const ATT_LAS float* wsh = wsf + 4 * hi;
#pragma unroll 1
    for (int c = 0; c < 2; ++c) {
        const int ch = h * 2 + c;
        bf16x8 qr[4];
#pragma unroll
        for (int d0 = 0; d0 < 4; ++d0) qr[d0] = *(const bf16x8*)(QA + m0 * 512 + ch * 64 + ((unsigned)r32 * 512u + (unsigned)hi * 8u + d0 * 16));
        const bf16_t* ksrc_u = KA + kv0 * 512 + ch * 64 + wid * 8; const unsigned koff = (unsigned)lane * 512u;
        const bf16_t* vsrc_u = VA + (kv0 + (wid & 3) * 16) * 512 + h * 128 + (wid >> 2) * 32; const unsigned voff = (unsigned)(lane >> 2) * 512u + (unsigned)(lane & 3) * 8u;
#define DMA_K(T) glds16(ksrc_u + koff + (size_t)(T) * 64 * 512, (unsigned)__builtin_amdgcn_readfirstlane(lds0 + (unsigned)(((T) & 3) * 8192 + wid * 1024)))
#define DMA_V(T) do { const bf16_t* vp_ = vsrc_u + voff + (size_t)(T) * 64 * 512; const unsigned vd_ = lds0 + (unsigned)(32768 + ((T) & 3) * 16384 + wid * 1024); \
            glds16(vp_, (unsigned)__builtin_amdgcn_readfirstlane(vd_)); glds16(vp_ + 64, (unsigned)__builtin_amdgcn_readfirstlane(vd_ + 8192u)); } while (0)
        DMA_K(0); DMA_V(0); DMA_K(1); DMA_V(1); DMA_K(2); DMA_V(2); DMA_K(3);
        asm volatile("s_waitcnt vmcnt(0) lgkmcnt(0)\n\ts_barrier" ::: "memory");
        f32x16 o[4];
#pragma unroll
        for (int d = 0; d < 4; ++d) o[d] = splat16(0.f);
        float mref = 0.f, l = 0.f; f32x16 negm = splat16(0.f); asm volatile("" : "+v"(negm));
        f32x16 p0, p1; u32x4 pw0 = {0u, 0u, 0u, 0u}, pw1 = pw0, pw2 = pw0, pw3 = pw0;
        qkt(p0, p1, (lds_cptr)lds, qr, r32, hi); asm volatile("s_nop 15\n\ts_nop 15" : "+v"(p0), "+v"(p1));
        { const float rm0 = rowmax_fast(p0, p1); mref = rm0;
#pragma unroll
          for (int r = 0; r < 16; ++r) { p0[r] -= rm0; p1[r] -= rm0; }
          negm = splat16(-mref); asm volatile("" : "+v"(negm)); }
#define DIFF_X(T, MASK) do { \
            if (MASK) { _Pragma("unroll") for (int r = 0; r < 16; ++r) { if (r >= 8) p0[r] = NEG_INF; p1[r] = NEG_INF; } } \
            const float rm = rowmax_fast(p0, p1); \
            if (__any(rm > 8.0f)) { const float dl = __builtin_fmaxf(rm, 0.f); mref += dl; \
                _Pragma("unroll") for (int r = 0; r < 16; ++r) { p0[r] -= dl; p1[r] -= dl; } \
                negm = splat16(-mref); asm volatile("" : "+v"(negm)); \
                const float f = __builtin_amdgcn_exp2f(-dl); l *= f; wsf[r32] = f; \
                _Pragma("unroll") for (int r = 0; r < 16; ++r) { const float fr_ = wsh[(r & 3) + 8 * (r >> 2)]; _Pragma("unroll") for (int d = 0; d < 4; ++d) o[d][r] *= fr_; } } \
            float s0 = 0.f, s1 = 0.f; \
            _Pragma("unroll") for (int r = 0; r < 16; ++r) { p0[r] = __builtin_amdgcn_exp2f(p0[r]); p1[r] = __builtin_amdgcn_exp2f(p1[r]); s0 += p0[r]; s1 += p1[r]; } \
            l += s0 + s1; \
            pw0 = (u32x4){cvtpk_s(p0[0], p0[1]), cvtpk_s(p0[2], p0[3]), cvtpk_s(p0[4], p0[5]), cvtpk_s(p0[6], p0[7])}; \
            pw1 = (u32x4){cvtpk_s(p0[8], p0[9]), cvtpk_s(p0[10], p0[11]), cvtpk_s(p0[12], p0[13]), cvtpk_s(p0[14], p0[15])}; \
            pw2 = (u32x4){cvtpk_s(p1[0], p1[1]), cvtpk_s(p1[2], p1[3]), cvtpk_s(p1[4], p1[5]), cvtpk_s(p1[6], p1[7])}; \
            pw3 = (u32x4){cvtpk_s(p1[8], p1[9]), cvtpk_s(p1[10], p1[11]), cvtpk_s(p1[12], p1[13]), cvtpk_s(p1[14], p1[15])}; } while (0)
#define DIFF_Y(T) do { VFrag vf_; const int vb_ = (int)(lds0 + 32768 + ((T) & 3) * 16384) + vlane; \
            pv4_issue0(vf_, vb_); \
            const bf16x8 pa0_ = __builtin_bit_cast(bf16x8, pw0), pa1_ = __builtin_bit_cast(bf16x8, pw1), pa2_ = __builtin_bit_cast(bf16x8, pw2), pa3_ = __builtin_bit_cast(bf16x8, pw3); \
            if ((T) + 1 < NKT) { qkt_c(p0, p1, (lds_cptr)(lds + (((T) + 1) & 3) * 8192), qr, negm, r32, hi); } \
            SBAR(); \
            pv4_rest(vf_, o, vb_, pa0_, pa1_, pa2_, pa3_); \
            asm volatile("s_nop 7" : "+v"(p0), "+v"(p1)); } while (0)
#define DIFF_STAGE(T) do { if ((T) + 4 < NKT) DMA_K((T) + 4); if ((T) + 3 < NKT) DMA_V((T) + 3); } while (0)
#define DIFF_BARV(T) do { if ((T) + 6 < NKT) asm volatile("s_waitcnt vmcnt(6) lgkmcnt(0)\n\ts_barrier" ::: "memory"); else asm volatile("s_waitcnt vmcnt(0) lgkmcnt(0)\n\ts_barrier" ::: "memory"); } while (0)
#define DIFF_PINX() asm volatile("" : "+v"(pw0), "+v"(pw1), "+v"(pw2), "+v"(pw3), "+v"(l))
#pragma unroll 1
        for (int t = 0; t < NKT - 1; ++t) {
            if (grp == 1) { DIFF_BARV(t); DIFF_STAGE(t); }
            DIFF_X(t, false);
            DIFF_PINX();
            if (grp == 0) { DIFF_BARV(t); DIFF_STAGE(t); }
            DIFF_Y(t);
        }
        {
            if (grp == 1) DIFF_BARV(NKT - 1);
            DIFF_X(NKT - 1, true);
            DIFF_PINX();
            if (grp == 0) DIFF_BARV(NKT - 1);
            DIFF_Y(NKT - 1);
        }
        asm volatile("s_waitcnt vmcnt(0) lgkmcnt(0)\n\ts_barrier" ::: "memory");
#undef DIFF_BARV
#undef DIFF_PINX
#undef DIFF_STAGE
#undef DIFF_X
#undef DIFF_Y
#undef DMA_K
#undef DMA_V
        const float lt = l + __shfl_xor(l, 32); const float il = 1.0f / lt;
        wsf[r32] = il;
        __hip_bfloat16* obase = (__hip_bfloat16*)ATT + (m0 + 4 * hi) * 1024 + h * 128 + r32; asm volatile("" : "+v"(obase));
        if (c == 0) {
#pragma unroll
            for (int r = 0; r < 16; ++r) { const float rl = wsh[(r & 3) + 8 * (r >> 2)]; __hip_bfloat16* orow = obase + (size_t)((r & 3) + 8 * (r >> 2)) * 1024;
#pragma unroll
                for (int d = 0; d < 4; ++d) orow[d * 32] = __float2bfloat16(o[d][r] * rl); }
        } else {
#pragma unroll
            for (int r = 0; r < 16; ++r) { const float rl = wsh[(r & 3) + 8 * (r >> 2)]; float q = 0.f; __hip_bfloat16* orow = obase + (size_t)((r & 3) + 8 * (r >> 2)) * 1024;
#pragma unroll
                for (int d = 0; d < 4; ++d) { const float a0 = __bfloat162float(orow[d * 32]); const float v = a0 - lam * (o[d][r] * rl); o[d][r] = v; q += v * v; }
                q += __shfl_xor(q, 1); q += __shfl_xor(q, 2); q += __shfl_xor(q, 4); q += __shfl_xor(q, 8); q += __shfl_xor(q, 16);
                const float rs = __builtin_amdgcn_rsqf(q * (1.0f / 128.0f) + 1e-6f);
#pragma unroll
                for (int d = 0; d < 4; ++d) orow[d * 32] = __float2bfloat16(o[d][r] * rs); }
        }
    }
}

__device__ __forceinline__ void win_unit(int b, int qb, const bf16_t* QBW, const bf16_t* KB, const bf16_t* VB, bf16_t* ATT, const float* sink, lds_ptr lds, unsigned lds0, const int tid) {
    const int lane = tid & 63, r32 = lane & 31, hi = lane >> 5; const int wid = __builtin_amdgcn_readfirstlane(tid >> 6);
    const int hq = wid, hk = wid >> 2; const int q0 = qb * 32; const size_t m0 = (size_t)b * NREAL + q0; const size_t kv0 = (size_t)b * KVROWS;
    const int vlane = ((lane >> 4) & 1) * 32 + (lane & 3) * 8 + (4 * hi + ((lane & 15) >> 2)) * 64;
    ATT_LAS float* wsf = (ATT_LAS float*)(lds + 131072 + wid * 256); const ATT_LAS float* wsh = wsf + 4 * hi;
    bf16x8 qr[4];
#pragma unroll
    for (int d0 = 0; d0 < 4; ++d0) qr[d0] = *(const bf16x8*)(QBW + m0 * 512 + hq * 64 + ((unsigned)r32 * 512u + (unsigned)hi * 8u + d0 * 16));
    f32x16 o[2]; o[0] = splat16(0.f); o[1] = splat16(0.f);
    float mref = 0.f, l = (hi == 0) ? __builtin_amdgcn_exp2f(sink[hq] * 1.4426950408889634f) : 0.f;
    int jlo = (q0 - 128) >> 6; if (jlo < 0) jlo = 0; int jhi = (q0 + 31 + 128) >> 6; if (jhi > 127) jhi = 127; const int nt = jhi - jlo + 2;
    const bf16_t* ksrc_u = KB + kv0 * 128 + wid * 8; const unsigned koff = (unsigned)lane * 128u;
    const bf16_t* vsrc_u = VB + (kv0 + (wid & 3) * 16) * 128 + (wid >> 2) * 32; const unsigned voff = (unsigned)(lane >> 2) * 128u + (unsigned)(lane & 3) * 8u;
#define ksrc (ksrc_u + koff)
#define vsrc (vsrc_u + voff)
    u32x4 k0r, k1r, v0r, v1r;
    { const size_t adv = (size_t)jlo * 64 * 128; k0r = *(const u32x4*)(ksrc + adv); k1r = *(const u32x4*)(ksrc + adv + 64); v0r = *(const u32x4*)(vsrc + adv); v1r = *(const u32x4*)(vsrc + adv + 64); }
    *(ATT_LAS u32x4*)(lds + wid * 1024 + lane * 16) = k0r; *(ATT_LAS u32x4*)(lds + 8192 + wid * 1024 + lane * 16) = k1r;
    *(ATT_LAS u32x4*)(lds + 16384 + tid * 16) = v0r; *(ATT_LAS u32x4*)(lds + 24576 + tid * 16) = v1r;
    __syncthreads();
#pragma unroll 1
    for (int i = 0; i < nt; ++i) {
        const int j = (i < nt - 1) ? jlo + i : 128; const int buf = i & 1;
        if (i + 1 < nt) { const int jn = (i + 1 < nt - 1) ? jlo + i + 1 : 128; const size_t adv = (size_t)jn * 64 * 128;
            k0r = *(const u32x4*)(ksrc + adv); k1r = *(const u32x4*)(ksrc + adv + 64); v0r = *(const u32x4*)(vsrc + adv); v1r = *(const u32x4*)(vsrc + adv + 64); }
        { f32x16 p0, p1;
            qkt(p0, p1, (lds_cptr)(lds + buf * 32768 + hk * 8192), qr, r32, hi); asm volatile("s_nop 15\n\ts_nop 15" : "+v"(p0), "+v"(p1));
            if (j == 128) {
#pragma unroll
                for (int r = 0; r < 16; ++r) { if (r >= 8) p0[r] = NEG_INF; p1[r] = NEG_INF; }
            } else if (!(64 * j + 63 <= q0 + 128 && 64 * j >= q0 - 97)) { const int dq = 64 * j - (q0 + r32);
#pragma unroll
                for (int r = 0; r < 16; ++r) { const int d0_ = dq + crow(r, hi), d1_ = d0_ + 32;
                    if (d0_ > 128 || d0_ < -128) p0[r] = NEG_INF; if (d1_ > 128 || d1_ < -128) p1[r] = NEG_INF; } }
            softmax_pv<2>(p0, p1, mref, l, o, (int)(lds0 + buf * 32768 + 16384 + hk * 8192) + vlane, r32, wsf, wsh);
        }
        if (i + 1 < nt) { const int nb = buf ^ 1;
            *(ATT_LAS u32x4*)(lds + nb * 32768 + wid * 1024 + lane * 16) = k0r; *(ATT_LAS u32x4*)(lds + nb * 32768 + 8192 + wid * 1024 + lane * 16) = k1r;
            *(ATT_LAS u32x4*)(lds + nb * 32768 + 16384 + tid * 16) = v0r; *(ATT_LAS u32x4*)(lds + nb * 32768 + 24576 + tid * 16) = v1r; }
        __syncthreads();
    }
#undef ksrc
#undef vsrc
    ATT_LAS float* ssx = (ATT_LAS float*)(lds + 65536);
    { const float lt = l + __shfl_xor(l, 32); const float il = 1.0f / lt;
        wsf[r32] = il;
#pragma unroll
        for (int r = 0; r < 16; ++r) { const float rl = wsh[(r & 3) + 8 * (r >> 2)]; o[0][r] *= rl; o[1][r] *= rl;
            float q = o[0][r] * o[0][r] + o[1][r] * o[1][r];
            q += __shfl_xor(q, 1); q += __shfl_xor(q, 2); q += __shfl_xor(q, 4); q += __shfl_xor(q, 8); q += __shfl_xor(q, 16);
            if (r32 == 0) ssx[wid * 32 + crow(r, hi)] = q; } }
    __syncthreads();
    __hip_bfloat16* wbase = (__hip_bfloat16*)ATT + (m0 + 4 * hi) * 1024 + 512 + hq * 64 + r32; asm volatile("" : "+v"(wbase));
#pragma unroll
    for (int r = 0; r < 16; ++r) { const int rr = crow(r, hi); float tot = 0.f;
#pragma unroll
        for (int w = 0; w < 8; ++w) tot += ssx[w * 32 + rr];
        const float rs = __builtin_amdgcn_rsqf(tot * (1.0f / 512.0f) + 1e-6f);
        __hip_bfloat16* orow = wbase + (size_t)((r & 3) + 8 * (r >> 2)) * 1024;
        orow[0] = __float2bfloat16(o[0][r] * rs); orow[32] = __float2bfloat16(o[1][r] * rs); }
    __syncthreads();
}
#undef SBAR
}
constexpr int NWAVES = 8;
constexpr int BATCH = 4, SEQ = 8192, DM = 1024, NMETA = 16, DFF = 2816, INW = 2304, LTOT = SEQ + NMETA;
constexpr int M = BATCH * SEQ;
constexpr int KVROWS = att::KVROWS;
constexpr size_t MiB = 1u << 20;
constexpr size_t WS_SS = 0;
constexpr size_t WS_SSM = 4 * (size_t)M * 4;
constexpr size_t WS_META = 1 * MiB;
constexpr size_t WS_ROPE = 2 * MiB;
constexpr size_t WS_WGU1 = 5 * MiB, WS_WD1 = 16 * MiB, WS_WIN = 22 * MiB, WS_WOUT = 27 * MiB, WS_WGU2 = 29 * MiB, WS_WD2 = 40 * MiB;
constexpr size_t WS_XB = 46 * MiB;
constexpr size_t WS_ATT = 110 * MiB;
constexpr size_t WS_HID = 174 * MiB;
constexpr size_t WS_QA = 174 * MiB, WS_QB = 206 * MiB, WS_KA = 238 * MiB, WS_VA = 271 * MiB, WS_KB = 304 * MiB, WS_VB = 313 * MiB;
constexpr size_t WS_END = 350 * MiB;
static_assert(WS_KA + (size_t)BATCH * KVROWS * 512 * 2 <= WS_VA && WS_VA + (size_t)BATCH * KVROWS * 512 * 2 <= WS_KB && WS_KB + (size_t)BATCH * KVROWS * 128 * 2 <= WS_VB && WS_VB + (size_t)BATCH * KVROWS * 128 * 2 <= WS_END, "qkv map");
static_assert(WS_HID + (size_t)M * DFF * 2 <= WS_END && (size_t)LTOT * 64 * 4 <= 3 * MiB && WS_SSM + 256 <= WS_META, "ws map");
constexpr int LDS_BYTES = 147456;
#define LAS __attribute__((address_space(3)))
typedef unsigned short bf16;
typedef unsigned v4u __attribute__((ext_vector_type(4)));
typedef float f32x4 __attribute__((ext_vector_type(4)));
typedef short bf16x8 __attribute__((ext_vector_type(8)));
__device__ __forceinline__ unsigned f2bf(float f) { unsigned u = __builtin_bit_cast(unsigned, f); return (u + 0x7fffu + ((u >> 16) & 1u)) >> 16; }
__device__ __forceinline__ unsigned pk2(float lo, float hi) { return f2bf(lo) | (f2bf(hi) << 16); }
__device__ __forceinline__ float wave_sum(float v) {
#pragma unroll
    for (int o = 1; o < 64; o <<= 1) v += __shfl_xor(v, o);
    return v;
}
template <int RM> __device__ __forceinline__ int map_row(int n) {
    if (RM == 1) return (n >> 7) * 256 + (n & 127);
    if (RM == 2) return (n >> 7) * 256 + 128 + (n & 127);
    if (RM == 3) { const int t = n >> 8, r = n & 255, hl = r >> 6, e = r & 63; return t * 256 + (e >> 5) * 128 + hl * 32 + (e & 31); }
    return n;
}
template <int RM, int GM> __device__ __forceinline__ void p0_transpose_item(const float* W, int K, int N, bf16* WT, const float* g, const float* g2, LAS float* scr, int item, int lane) {
    const int nblk = N / 32, kb = item / nblk, nb = item % nblk, k0 = 64 * kb, n0 = 32 * nb;
    float wv[32];
#pragma unroll
    for (int i = 0; i < 32; ++i) wv[i] = __builtin_nontemporal_load(W + (size_t)(k0 + 2 * i + (lane >> 5)) * N + n0 + (lane & 31));
    float gv0 = 1.f, gv1 = 1.f;
    if (GM == 1) gv0 = g[k0 + lane];
    if (GM == 2) { const int k = k0 + lane; gv0 = (k < 512) ? g[k & 127] * 0.8f : g2[k - 512]; }
    (void)gv1;
#pragma unroll
    for (int i = 0; i < 32; ++i) { const int kk = 2 * i + (lane >> 5); const float gv = (GM == 0) ? 1.f : __shfl(gv0, kk);
        scr[kk * 33 + (lane & 31)] = wv[i] * gv; }
    asm volatile("s_waitcnt lgkmcnt(0)" ::: "memory");
    const int c = lane & 7;
#pragma unroll
    for (int j = 0; j < 4; ++j) { const int n = (lane >> 3) + 8 * j; const LAS float* s = scr + (8 * c) * 33 + n;
        v4u o; o.x = pk2(s[0 * 33], s[1 * 33]); o.y = pk2(s[2 * 33], s[3 * 33]); o.z = pk2(s[4 * 33], s[5 * 33]); o.w = pk2(s[6 * 33], s[7 * 33]);
        *(v4u*)(WT + (size_t)map_row<RM>(n0 + n) * K + k0 + 8 * c) = o; }
    asm volatile("s_waitcnt lgkmcnt(0)" ::: "memory");
}
__device__ __forceinline__ void row_to_bf16_ss(const float* xrow, bf16* orow, float* ssp, int lane) {
    const f32x4* xr = (const f32x4*)xrow + lane; f32x4 v[4]; float s = 0.f;
#pragma unroll
    for (int j = 0; j < 4; ++j) { v[j] = xr[64 * j]; s += (v[j].x * v[j].x + v[j].y * v[j].y) + (v[j].z * v[j].z + v[j].w * v[j].w); }
    s = wave_sum(s);
    unsigned long long* o8 = (unsigned long long*)orow + lane;
#pragma unroll
    for (int j = 0; j < 4; ++j) o8[64 * j] = (unsigned long long)pk2(v[j].x, v[j].y) | ((unsigned long long)pk2(v[j].z, v[j].w) << 32);
    if (lane == 0) *ssp = s;
}
__device__ __forceinline__ void meta_mma2(const bf16* A, const bf16* Bt0, const bf16* Bt1, int K, f32x4& c0, f32x4& c1, int lane) {
    const int fr = lane & 15, fq = lane >> 4; c0 = (f32x4){0.f, 0.f, 0.f, 0.f}; c1 = c0;
    const bf16* ap = A + (size_t)fr * K + 8 * fq; const bf16* b0p = Bt0 + (size_t)fr * K + 8 * fq; const bf16* b1p = Bt1 + (size_t)fr * K + 8 * fq;
#pragma unroll 4
    for (int k0 = 0; k0 < K; k0 += 32) { const bf16x8 a = *(const bf16x8*)(ap + k0), b0 = *(const bf16x8*)(b0p + k0), b1 = *(const bf16x8*)(b1p + k0);
        c0 = __builtin_amdgcn_mfma_f32_16x16x32_bf16(b0, a, c0, 0, 0, 0); c1 = __builtin_amdgcn_mfma_f32_16x16x32_bf16(b1, a, c1, 0, 0, 0); }
}

#define ss0 ((float*)(args.ws + WS_SS))
#define ss1 (ss0 + M)
#define ss2 (ss0 + 2 * M)
#define ss3 (ss0 + 3 * M)
#define ssm0 ((float*)(args.ws + WS_SSM))
#define ssm1 (ssm0 + 16)
#define metab ((bf16*)(args.ws + WS_META))
#define hidm (metab + 16 * 1024)
#define h1mb (hidm + 16 * DFF)
#define rope ((float*)(args.ws + WS_ROPE))
#define WGU1 ((bf16*)(args.ws + WS_WGU1))
#define WD1 ((bf16*)(args.ws + WS_WD1))
#define WIN ((bf16*)(args.ws + WS_WIN))
#define WOUT ((bf16*)(args.ws + WS_WOUT))
#define WGU2 ((bf16*)(args.ws + WS_WGU2))
#define WD2 ((bf16*)(args.ws + WS_WD2))
#define XB ((bf16*)(args.ws + WS_XB))
#define ATT ((bf16*)(args.ws + WS_ATT))
#define HID ((bf16*)(args.ws + WS_HID))
#define QA ((bf16*)(args.ws + WS_QA))
#define QBW ((bf16*)(args.ws + WS_QB))
#define KA ((bf16*)(args.ws + WS_KA))
#define VA ((bf16*)(args.ws + WS_VA))
#define KB ((bf16*)(args.ws + WS_KB))
#define VB ((bf16*)(args.ws + WS_VB))
#define RLX_AGENT __ATOMIC_RELAXED, __HIP_MEMORY_SCOPE_AGENT
constexpr size_t WS_BAR = 1 * MiB + 512 * 1024;
constexpr int BAR_ZERO_BYTES = 16384;
constexpr int MISC_OFF = LDS_BYTES - 64;
#define XB_TMO      128
#define XB_XCNT(j)  (256  + 64 * (j))
#define XB_XSUB(j)  (1280 + 64 * (j))
#define XB_XGEN(j)  (2304 + 64 * (j))
#define XB_TOP      3328
#define XB_TOPGEN   3392
#define XCD_BAR_WORDS 3456
#define XB_SPIN_CAP (1u << 18)

__device__ __forceinline__ unsigned xb_ld(unsigned* p)              { return __hip_atomic_load(p, __ATOMIC_RELAXED, __HIP_MEMORY_SCOPE_AGENT); }
__device__ __forceinline__ unsigned xb_add(unsigned* p, unsigned v) { return __hip_atomic_fetch_add(p, v, __ATOMIC_RELAXED, __HIP_MEMORY_SCOPE_AGENT); }
__device__ __forceinline__ unsigned xb_xcc_id() { return (unsigned)__builtin_amdgcn_s_getreg((3 << 11) | 20) & 0xFu; }
#define XB_SPIN(cond, bar) do { unsigned _sp = 0; while (cond) { __builtin_amdgcn_s_sleep(1); \
    if ((++_sp & 255u) == 0u) { if (xb_ld(&(bar)[XB_TMO])) break; if (_sp > XB_SPIN_CAP) { atomicAdd(&(bar)[XB_TMO], 1u); break; } } } } while (0)

struct XcdBarrier {
    unsigned* bar; unsigned x;
    volatile LAS unsigned* st;
};

__device__ __forceinline__ XcdBarrier xcd_barrier_post(unsigned* bar, volatile LAS unsigned* st, bool leader) {
    XcdBarrier b; b.bar = bar; b.x = xb_xcc_id(); b.st = st;
    if (leader) (void)xb_add(&bar[XB_XCNT(b.x)], 1u);
    return b;
}
__device__ __forceinline__ void xcd_barrier_complete(unsigned* bar, unsigned x, unsigned& nloc, unsigned& nx) {
    const unsigned G = gridDim.x * gridDim.y * gridDim.z;
    unsigned sum, cnt, mine, sp = 0u;
    for (;;) {
        sum = 0u; cnt = 0u; mine = 0u;
#pragma unroll
        for (unsigned j = 0; j < 16; ++j) { const unsigned c = xb_ld(&bar[XB_XCNT(j)]); sum += c; cnt += (c > 0u) ? 1u : 0u; mine = (j == x) ? c : mine; }
        if (sum == G) break;
        __builtin_amdgcn_s_sleep(1);
        if ((++sp & 255u) == 0u) { if (xb_ld(&bar[XB_TMO])) break; if (sp > XB_SPIN_CAP) { atomicAdd(&bar[XB_TMO], 1u); break; } }
    }
    nloc = mine > 0u ? mine : 1u; nx = cnt > 0u ? cnt : 1u;
}

__device__ __forceinline__ void xcd_barrier(const XcdBarrier& b, bool leader) {
    asm volatile("s_waitcnt vmcnt(0)" ::: "memory");
    __syncthreads();
    if (leader) {
        unsigned* bar = b.bar;
        __builtin_amdgcn_s_waitcnt(0);
        unsigned nloc = b.st[0], nx = b.st[1];
        if (nloc == 0u) { xcd_barrier_complete(bar, b.x, nloc, nx); b.st[0] = nloc; b.st[1] = nx; }
        const unsigned old = xb_add(&bar[XB_XSUB(b.x)], 1u);
        const unsigned gen = old / nloc;
        if (old + 1u == (gen + 1u) * nloc) {
            __builtin_amdgcn_fence(__ATOMIC_RELEASE, "agent");
            asm volatile("s_waitcnt vmcnt(0)" ::: "memory");
            const unsigned og = xb_add(&bar[XB_TOP], 1u);
            const unsigned tg = og / nx;
            if (og + 1u == (tg + 1u) * nx) xb_add(&bar[XB_TOPGEN], 1u);
            else XB_SPIN(xb_ld(&bar[XB_TOPGEN]) == tg, bar);
            __builtin_amdgcn_fence(__ATOMIC_ACQUIRE, "agent");
            xb_add(&bar[XB_XGEN(b.x)], 1u);
            asm volatile("s_waitcnt vmcnt(0)" ::: "memory");
        } else {
            XB_SPIN(xb_ld(&bar[XB_XGEN(b.x)]) == gen, bar);
            __builtin_amdgcn_fence(__ATOMIC_ACQUIRE, "agent");
            asm volatile("s_waitcnt vmcnt(0)" ::: "memory");
        }
    }
    __syncthreads();
}

struct Args { const float* in[21]; float* out; unsigned char* ws; int ph_lo, ph_hi; };
constexpr int N_PHASES = 9;

__global__ void __launch_bounds__(NWAVES * 64, 2) hymba_fwd(Args args) {
    extern __shared__ __attribute__((aligned(16))) unsigned char lds[];
    __builtin_assume(__builtin_amdgcn_workitem_id_y() == 0); __builtin_assume(__builtin_amdgcn_workitem_id_z() == 0);
    LAS unsigned char* L = (LAS unsigned char*)lds;
    const int wave0 = __builtin_amdgcn_readfirstlane((int)threadIdx.x >> 6);
    const int G = gridDim.x; const int bx = blockIdx.x; const int vcu = (G % 8 == 0) ? (bx % 8) * (G / 8) + bx / 8 : bx;
    const int NGW = G * NWAVES, NGT = G * NWAVES * 64;
#define PHASE_IDS const int lane = (int)__builtin_amdgcn_mbcnt_hi(~0u, __builtin_amdgcn_mbcnt_lo(~0u, 0u)); const int wave = wave0; const int tid = wave * 64 + lane; \
    const int gw = vcu * NWAVES + wave; const int gtid = vcu * (NWAVES * 64) + tid; (void)lane; (void)gw; (void)gtid;
    const float* const x = args.in[0]; float* const out = args.out;
    const int lo = args.ph_lo, hi_ = args.ph_hi;
    XcdBarrier xbar; xbar.bar = (unsigned*)(args.ws + WS_BAR); xbar.x = 0; xbar.st = nullptr;
    const bool one_launch = (lo == 0 && hi_ == N_PHASES);
    if (one_launch) {
        const int lane0 = (int)__builtin_amdgcn_mbcnt_hi(~0u, __builtin_amdgcn_mbcnt_lo(~0u, 0u)); const bool leader0 = (wave0 == 0 && lane0 == 0);
        volatile LAS unsigned* st = (volatile LAS unsigned*)(L + MISC_OFF);
        if (leader0) { st[0] = 0u; st[1] = 0u; }
        __syncthreads();
        xbar = xcd_barrier_post((unsigned*)(args.ws + WS_BAR), st, leader0);
    }
#ifndef PHMASK
#define PHMASK 0x1ff
#endif
#define IN(k) (((PHMASK >> (k)) & 1) && lo <= (k) && (k) < hi_)
#define SEAM(k) do { if (IN(k) && IN((k) + 1)) { if (lo < 0) cg::this_grid().sync();     \
        const int lane_ = (int)__builtin_amdgcn_mbcnt_hi(~0u, __builtin_amdgcn_mbcnt_lo(~0u, 0u)); xcd_barrier(xbar, wave0 == 0 && lane_ == 0); } } while (0)

    if (IN(0)) { PHASE_IDS
        LAS float* scr = (LAS float*)(L + wave * 16384);
        constexpr int I_GU = (DM / 64) * (DFF / 32), I_DN = (DFF / 64) * (DM / 32), I_IN = (DM / 64) * (INW / 32), I_OUT = (DM / 64) * (DM / 32);
        constexpr int NITEMS = 4 * I_GU + 2 * I_DN + I_IN + I_OUT;
        for (int it = gw; it < NITEMS; it += NGW) {
            int r = it;
            if (r < I_GU) { p0_transpose_item<1, 1>(args.in[3], DM, DFF, WGU1, args.in[2], nullptr, scr, r, lane); continue; } r -= I_GU;
            if (r < I_GU) { p0_transpose_item<2, 1>(args.in[4], DM, DFF, WGU1, args.in[2], nullptr, scr, r, lane); continue; } r -= I_GU;
            if (r < I_GU) { p0_transpose_item<1, 1>(args.in[17], DM, DFF, WGU2, args.in[16], nullptr, scr, r, lane); continue; } r -= I_GU;
            if (r < I_GU) { p0_transpose_item<2, 1>(args.in[18], DM, DFF, WGU2, args.in[16], nullptr, scr, r, lane); continue; } r -= I_GU;
            if (r < I_DN) { p0_transpose_item<0, 0>(args.in[5], DFF, DM, WD1, nullptr, nullptr, scr, r, lane); continue; } r -= I_DN;
            if (r < I_DN) { p0_transpose_item<0, 0>(args.in[19], DFF, DM, WD2, nullptr, nullptr, scr, r, lane); continue; } r -= I_DN;
            if (r < I_IN) { p0_transpose_item<3, 1>(args.in[7], DM, INW, WIN, args.in[6], nullptr, scr, r, lane); continue; } r -= I_IN;
            p0_transpose_item<0, 2>(args.in[15], DM, DM, WOUT, args.in[12], args.in[14], scr, r, lane);
        }
        for (int m = gw; m < M; m += NGW) row_to_bf16_ss(x + (size_t)m * DM, XB + (size_t)m * DM, ss0 + m, lane);
        if (gw < 16) row_to_bf16_ss(args.in[1] + (size_t)gw * DM, metab + (size_t)gw * DM, ssm0 + gw, lane);
        for (int i = gtid; i < 3 * M; i += NGT) ss1[i] = 0.f;
        if (gtid < 16) ssm1[gtid] = 0.f;
        for (int i = gtid; i < LTOT * 32; i += NGT) { const int pos = i >> 5, k = i & 31;
            const float inv = exp2f(-(float)k * (13.287712379549449f / 32.0f)); const float ang = (float)pos * inv;
            rope[(size_t)pos * 64 + k] = cosf(ang); rope[(size_t)pos * 64 + 32 + k] = sinf(ang); }
    }
    SEAM(0);
    if (IN(1)) { PHASE_IDS
        if (gw < DFF / 16) { const int j = gw, t = j >> 3, within = (j & 7) * 16; const bf16* B0 = WGU1 + (size_t)(t * 256 + within) * DM; f32x4 c0, c1;
            meta_mma2(metab, B0, B0 + (size_t)128 * DM, DM, c0, c1, lane);
            const int fr = lane & 15, fq = lane >> 4; const float rs = pg8::rstd1024(ssm0[fr]);
#pragma unroll
            for (int e = 0; e < 4; ++e) hidm[(size_t)fr * DFF + j * 16 + 4 * fq + e] = (bf16)f2bf(pg8::silu_mul(c0[e] * rs, c1[e] * rs)); }
        pg8::Gemm g{XB, WGU1, M, 2 * DFF, DM}; pg8::StaticOrder S; S.init(M, 2 * DFF, G, bx);
        pg8::EpiSwiGLU E{HID, DFF, ss0};
        pg8::gemm_phase<pg8::EpiSwiGLU, pg8::StaticOrder, true, true>(L, g, S, E, tid);
    }
    SEAM(1);
    if (IN(2)) { PHASE_IDS
        if (gw < DM / 16) { const int n0 = gw * 16; f32x4 c0, c1; const bf16* B0 = WD1 + (size_t)n0 * DFF;
            meta_mma2(hidm, B0, B0, DFF, c0, c1, lane);
            const int fr = lane & 15, fq = lane >> 4; float q = 0.f;
#pragma unroll
            for (int e = 0; e < 4; ++e) { const int n = n0 + 4 * fq + e; const float v = args.in[1][(size_t)fr * DM + n] + 0.5f * c0[e]; h1mb[(size_t)fr * DM + n] = (bf16)f2bf(v); q += v * v; }
            q += __shfl_xor(q, 16); q += __shfl_xor(q, 32);
            if (fq == 0) __hip_atomic_fetch_add(ssm1 + fr, q, __ATOMIC_RELAXED, __HIP_MEMORY_SCOPE_AGENT); }
        pg8::Gemm g{HID, WD1, M, DM, DFF}; pg8::StaticOrder S; S.init(M, DM, G, bx);
        pg8::EpiResid<true> E{x, out, XB, ss1, 0.5f, DM};
        pg8::gemm_phase<pg8::EpiResid<true>, pg8::StaticOrder, true, true>(L, g, S, E, tid);
    }
    SEAM(2);
    if (IN(3)) { PHASE_IDS
        if (gw < 40) { const int ti = gw >> 3, j = gw & 7, t = (ti < 4) ? ti + 2 : 8, hl = j >> 1, i0 = (j & 1) * 16; f32x4 c0, c1;
            const bf16* B0 = WIN + (size_t)(t * 256 + hl * 32 + i0) * DM; meta_mma2(h1mb, B0, B0 + (size_t)128 * DM, DM, c0, c1, lane);
            const int fr = lane & 15, fq = lane >> 4, i = i0 + 4 * fq; const float rs = pg8::rstd1024(ssm1[fr]);
            bf16* dst; int ld, col; bool do_rope;
            if (t < 4) { dst = KA; ld = 512; col = ((t - 2) * 4 + hl) * 64; do_rope = true; }
            else if (t < 6) { dst = VA; ld = 512; col = (t - 4) * 256 + hl * 64; do_rope = false; }
            else if (hl < 2) { dst = KB; ld = 128; col = hl * 64; do_rope = true; }
            else { dst = VB; ld = 128; col = (hl - 2) * 64; do_rope = false; }
            float x1[4], x2[4];
#pragma unroll
            for (int e = 0; e < 4; ++e) { x1[e] = c0[e] * rs; x2[e] = c1[e] * rs;
                if (do_rope) { const float cs = rope[(size_t)fr * 64 + i + e], sn = rope[(size_t)fr * 64 + 32 + i + e]; const float a = x1[e] * cs - x2[e] * sn, b_ = x2[e] * cs + x1[e] * sn; x1[e] = a; x2[e] = b_; } }
            const unsigned long long w1 = (unsigned long long)pk2(x1[0], x1[1]) | ((unsigned long long)pk2(x1[2], x1[3]) << 32), w2 = (unsigned long long)pk2(x2[0], x2[1]) | ((unsigned long long)pk2(x2[2], x2[3]) << 32);
            for (int b = 0; b < BATCH; ++b) { bf16* p = dst + ((size_t)b * KVROWS + SEQ + fr) * ld + col + i; *(unsigned long long*)p = w1; *(unsigned long long*)(p + 32) = w2; } }
        { constexpr int PA = BATCH * 48 * 512 / 8, PB = BATCH * 48 * 128 / 8;
            for (int i = gtid; i < 2 * PA + 2 * PB; i += NGT) { int r = i; bf16* base; int ld;
                if (r < PA) { base = KA; ld = 512; } else if ((r -= PA) < PA) { base = VA; ld = 512; } else if ((r -= PA) < PB) { base = KB; ld = 128; } else { r -= PB; base = VB; ld = 128; }
                const int per_row = ld / 8, rowi = r / per_row, cpiece = r % per_row, b = rowi / 48, pr = rowi % 48;
                *(v4u*)(base + ((size_t)b * KVROWS + LTOT + pr) * ld + cpiece * 8) = (v4u){0u, 0u, 0u, 0u}; } }
        pg8::Gemm g{XB, WIN, M, INW, DM}; pg8::StaticOrder S; S.init(M, INW, G, bx);
        pg8::EpiQKV E{QA, KA, VA, QBW, KB, VB, ss1, rope};
        pg8::gemm_phase<pg8::EpiQKV, pg8::StaticOrder, true, true>(L, g, S, E, tid);
    }
    SEAM(3);
    if (IN(4)) { PHASE_IDS
        float lam;
        { const float a = args.in[8][lane] * args.in[9][lane], b_ = args.in[10][lane] * args.in[11][lane]; lam = expf(wave_sum(a)) - expf(wave_sum(b_)) + 0.2f; }
        const unsigned lds0 = (unsigned)(uintptr_t)lds;
        const int NDU = BATCH * 4 * (SEQ / 256), NWU = BATCH * (SEQ / 32);
        { const int per = (NDU + G - 1) / G; for (int u = vcu * per; u < (vcu + 1) * per && u < NDU; ++u) { const int bh = u >> 5, qb = u & 31; att::diff_unit(bh >> 2, bh & 3, qb, QA, KA, VA, ATT, lam, (att::lds_ptr)L, lds0, tid); } }
        { const int per = (NWU + G - 1) / G; for (int u = vcu * per; u < (vcu + 1) * per && u < NWU; ++u) { att::win_unit(u >> 8, u & 255, QBW, KB, VB, ATT, args.in[13], (att::lds_ptr)L, lds0, tid); } }
    }
    SEAM(4);
    if (IN(5)) { PHASE_IDS
        pg8::Gemm g{ATT, WOUT, M, DM, DM}; pg8::StaticOrder S; S.init(M, DM, G, bx);
        pg8::EpiResid<true> E{out, out, XB, ss2, 1.0f, DM};
        pg8::gemm_phase<pg8::EpiResid<true>, pg8::StaticOrder, true, true>(L, g, S, E, tid);
    }
    SEAM(5);
    if (IN(6)) { PHASE_IDS
        pg8::Gemm g{XB, WGU2, M, 2 * DFF, DM}; pg8::StaticOrder S; S.init(M, 2 * DFF, G, bx);
        pg8::EpiSwiGLU E{HID, DFF, ss2};
        pg8::gemm_phase<pg8::EpiSwiGLU, pg8::StaticOrder, true, true>(L, g, S, E, tid);
    }
    SEAM(6);
    if (IN(7)) { PHASE_IDS
        pg8::Gemm g{HID, WD2, M, DM, DFF}; pg8::StaticOrder S; S.init(M, DM, G, bx);
        pg8::EpiResid<false> E{out, out, nullptr, ss3, 0.5f, DM};
        pg8::gemm_phase<pg8::EpiResid<false>, pg8::StaticOrder, true, true>(L, g, S, E, tid);
    }
    SEAM(7);
    if (IN(8)) { PHASE_IDS
        const f32x4* gn = (const f32x4*)args.in[20] + lane;
        for (int m = gw; m < M; m += NGW) { const float rs = pg8::rstd1024(ss3[m]); f32x4* o = (f32x4*)(out + (size_t)m * DM) + lane;
#pragma unroll
            for (int j = 0; j < 4; ++j) o[64 * j] = o[64 * j] * rs * gn[64 * j]; }
    }
#undef IN
#undef SEAM
}

extern "C" void kernel_launch(void* const* d_in, const int* in_sizes, int n_in, void* d_out, int out_size, void* d_ws, size_t ws_size, hipStream_t stream) {
    static int grid = 0;
    if (grid == 0) {
        if (n_in != 21 || out_size != M * DM || ws_size < WS_END) { fprintf(stderr, "kernel_launch: unexpected shapes (n_in %d out %d ws %zu)\n", n_in, out_size, ws_size); grid = -1; return; }
        int dev = 0, cus = 0, per_cu = 0;
        if (hipGetDevice(&dev) != hipSuccess || hipDeviceGetAttribute(&cus, hipDeviceAttributeMultiprocessorCount, dev) != hipSuccess) { grid = -1; return; }
        if (hipFuncSetAttribute((const void*)hymba_fwd, hipFuncAttributeMaxDynamicSharedMemorySize, LDS_BYTES) != hipSuccess) { fprintf(stderr, "kernel_launch: hipFuncSetAttribute failed\n"); grid = -1; return; }
        if (hipOccupancyMaxActiveBlocksPerMultiprocessor(&per_cu, (const void*)hymba_fwd, NWAVES * 64, LDS_BYTES) != hipSuccess || per_cu < 1) { fprintf(stderr, "kernel_launch: occupancy query says %d\n", per_cu); per_cu = 1; }
        (void)hipGetLastError();
        grid = cus;
    }
    if (grid < 0) return;
    Args a{};
    for (int i = 0; i < 21; ++i) a.in[i] = (const float*)d_in[i];
    a.out = (float*)d_out; a.ws = (unsigned char*)d_ws;
#if MK_ONE_LAUNCH
    a.ph_lo = 0; a.ph_hi = N_PHASES;
    if (hipMemsetAsync((char*)d_ws + WS_BAR, 0, BAR_ZERO_BYTES, stream) != hipSuccess) { fprintf(stderr, "kernel_launch: memset of the barrier words failed\n"); return; }
    void* kargs[] = {&a};
    hipError_t e = hipLaunchCooperativeKernel((const void*)hymba_fwd, dim3(grid), dim3(NWAVES * 64), kargs, LDS_BYTES, stream);
    if (e != hipSuccess) fprintf(stderr, "kernel_launch: cooperative launch failed: %s (grid %d)\n", hipGetErrorString(e), grid);
#else
    for (int p = 0; p < N_PHASES; ++p) { a.ph_lo = p; a.ph_hi = p + 1; hipLaunchKernelGGL(hymba_fwd, dim3(grid), dim3(NWAVES * 64), LDS_BYTES, stream, a); }
#endif
}
```

```cpp
#include <hip/hip_runtime.h>
#include <hip/hip_cooperative_groups.h>
#include <hip/hip_bf16.h>
#include <cstdio>
#include <cstdint>
namespace cg = cooperative_groups;
#ifndef MK_ONE_LAUNCH
#define MK_ONE_LAUNCH 1
#endif
namespace pg8 {
#define PG8_LAS __attribute__((address_space(3)))
typedef unsigned short bf16_t;
typedef short bf16x8 __attribute__((ext_vector_type(8)));
typedef float f32x4 __attribute__((ext_vector_type(4)));
typedef unsigned u32x4 __attribute__((ext_vector_type(4)));
constexpr int BM = 256, BK = 64, HALF = 128, HTB = HALF * BK * 2  , STAGE_BYTES = 8 * HTB, NXCD = 8, WGM = 8;

__host__ __device__ __forceinline__ int lds_byte(int r, int c) { const int st = (r >> 4) * 2 + (c >> 5), rr = r & 15, cc = c & 31, ob = rr * 64 + cc * 2; return st * 1024 + (ob ^ (((ob >> 9) & 1) << 5)); }
__host__ __device__ __forceinline__ void stage_rc(int b, int& R, int& C) { const int st = b / 1024, sb = b % 1024, swz = sb ^ (((sb >> 9) & 1) << 5); R = (st >> 1) * 16 + swz / 64; C = (st & 1) * 32 + (swz % 64) / 2; }
__host__ __device__ __forceinline__ int perm32(int rho) { const int n = rho >> 4, i = rho & 15; return 8 * (i >> 2) + 4 * n + (i & 3); }

struct Unit { int pm, pn; };
struct Gemm { const bf16_t* A; const bf16_t* Bt; int M, N, K; };

struct StaticOrder {
    int nM, nN, nwg, G, c;
    __host__ __device__ void init(int M, int N, int G_, int c_) { nM = M / BM; nN = N / BM; nwg = nM * nN; G = G_; c = c_; }
    __host__ __device__ bool next(int i, Unit& u) const {
        const long L = (long)i * G + c; if (L >= nwg) return false;
        int wgid = (int)L; { const int q = nwg / NXCD, r = nwg % NXCD, xcd = wgid % NXCD, off = wgid / NXCD; wgid = (xcd < r ? xcd * (q + 1) : r * (q + 1) + (xcd - r) * q) + off; }
        const int nig = WGM * nN, gid = wgid / nig, fm = gid * WGM, gsz = (nM - fm) < WGM ? (nM - fm) : WGM;
        u.pm = fm + ((wgid % nig) % gsz); u.pn = (wgid % nig) / gsz; return true;
    }
    __device__ __forceinline__ void a_ready(const Unit&) const {}
    __device__ __forceinline__ void done(const Unit&) const {}
};

__device__ __forceinline__ unsigned cvt_pk_bf16(float lo, float hi) { unsigned r; asm volatile("v_cvt_pk_bf16_f32 %0, %1, %2" : "=v"(r) : "v"(lo), "v"(hi)); return r; }
typedef float f32x2 __attribute__((ext_vector_type(2)));
constexpr float RMS_EPS = 1e-6f;
__device__ __forceinline__ float rstd1024(float ss) { return __builtin_amdgcn_rsqf(ss * (1.0f / 1024.0f) + RMS_EPS); }
__device__ __forceinline__ float silu_mul(float g, float u) { return g * __builtin_amdgcn_rcpf(1.0f + __builtin_amdgcn_exp2f(-1.4426950408889634f * g)) * u; }

struct EpiSwiGLU {
    static constexpr bool PERM = true, AFTER_DRAIN = false;
    bf16_t* H; int ldh; const float* ss;
    __device__ __forceinline__ void operator()(const f32x4 (&acc)[2][2][4][2], const Unit& u, int wr, int wc, int fr, int fq) const {
        const int row0 = u.pm * BM + wr * 64 + fr; const int col0 = u.pn * HALF + wc * 32 + 8 * fq;
        float v8[8];
#pragma unroll
        for (int i = 0; i < 8; ++i) v8[i] = ss[row0 + (i >> 2) * HALF + (i & 3) * 16];
#pragma unroll
        for (int ai = 0; ai < 2; ++ai)
#pragma unroll
            for (int m = 0; m < 4; ++m) { const int row = row0 + ai * HALF + m * 16; const float v = v8[ai * 4 + m] * (1.0f / 1024.0f) + RMS_EPS;
                const float rs = __builtin_amdgcn_rsqf(v); const float a = rs * -1.4426950408889634f;
                float h[8];
#pragma unroll
                for (int n = 0; n < 2; ++n)
#pragma unroll
                    for (int e = 0; e < 4; ++e) { const float g = acc[ai][0][m][n][e], uu = acc[ai][1][m][n][e];
                        const float ex = __builtin_amdgcn_exp2f(g * a); const float r = __builtin_amdgcn_rcpf(__builtin_fmaf(ex, v, v)); h[n * 4 + e] = (g * uu) * r; }
                u32x4 w; w.x = cvt_pk_bf16(h[0], h[1]); w.y = cvt_pk_bf16(h[2], h[3]); w.z = cvt_pk_bf16(h[4], h[5]); w.w = cvt_pk_bf16(h[6], h[7]);
                *(u32x4*)(H + (size_t)row * ldh + col0) = w; }
    }
};
typedef unsigned u32x2 __attribute__((ext_vector_type(2)));
template <bool WB> struct EpiResid {
    static constexpr bool PERM = true, AFTER_DRAIN = false;
    const float* base; float* out; bf16_t* outb; float* ssout; float alpha; int ldc;
    __device__ __forceinline__ void operator()(const f32x4 (&acc)[2][2][4][2], const Unit& u, int wr, int wc, int fr, int fq) const {
        const int row0 = u.pm * BM + wr * 64 + fr; const int col0 = u.pn * BM + wc * 32 + 8 * fq;
#pragma unroll
        for (int ai = 0; ai < 2; ++ai)
#pragma unroll
            for (int m = 0; m < 4; ++m) { const int row = row0 + ai * HALF + m * 16; const size_t off = (size_t)row * ldc + col0; float q = 0.f;
#pragma unroll
                for (int bj = 0; bj < 2; ++bj) { const f32x4 b0 = *(const f32x4*)(base + off + bj * HALF), b1 = *(const f32x4*)(base + off + bj * HALF + 4);
                    const f32x4 o0 = b0 + acc[ai][bj][m][0] * alpha, o1 = b1 + acc[ai][bj][m][1] * alpha;
                    *(f32x4*)(out + off + bj * HALF) = o0; *(f32x4*)(out + off + bj * HALF + 4) = o1;
                    q += (o0[0] * o0[0] + o0[1] * o0[1]) + (o0[2] * o0[2] + o0[3] * o0[3]) + (o1[0] * o1[0] + o1[1] * o1[1]) + (o1[2] * o1[2] + o1[3] * o1[3]);
                    if (WB) { u32x4 w; w.x = cvt_pk_bf16(o0[0], o0[1]); w.y = cvt_pk_bf16(o0[2], o0[3]); w.z = cvt_pk_bf16(o1[0], o1[1]); w.w = cvt_pk_bf16(o1[2], o1[3]); *(u32x4*)(outb + off + bj * HALF) = w; } }
                q += __shfl_xor(q, 16); q += __shfl_xor(q, 32);
                if (fq == 0) __hip_atomic_fetch_add(ssout + row, q, __ATOMIC_RELAXED, __HIP_MEMORY_SCOPE_AGENT); }
    }
};
constexpr float QK_C2 = 0.125f * 1.4426950408889634f;
struct EpiQKV {
    static constexpr bool PERM = true, AFTER_DRAIN = false;
    bf16_t *QA, *KA, *VA, *QBW, *KB, *VB; const float* ss; const float* rope;
    __device__ __forceinline__ void operator()(const f32x4 (&acc)[2][2][4][2], const Unit& u, int wr, int wc, int fr, int fq) const {
        const int t = u.pn, hl = wc, i0 = 8 * fq; const int row0 = u.pm * BM + wr * 64 + fr;
        bf16_t* dst; int ld, col; bool do_rope, kv; float sc = 1.f;
        if (t < 2) { dst = QA; ld = 512; col = (t * 4 + hl) * 64; do_rope = true; kv = false; sc = QK_C2; }
        else if (t < 4) { dst = KA; ld = 512; col = ((t - 2) * 4 + hl) * 64; do_rope = true; kv = true; }
        else if (t < 6) { dst = VA; ld = 512; col = (t - 4) * 256 + hl * 64; do_rope = false; kv = true; }
        else if (t < 8) { dst = QBW; ld = 512; col = ((t - 6) * 4 + hl) * 64; do_rope = true; kv = false; sc = QK_C2; }
        else if (hl < 2) { dst = KB; ld = 128; col = hl * 64; do_rope = true; kv = true; }
        else { dst = VB; ld = 128; col = (hl - 2) * 64; do_rope = false; kv = true; }
        float rs8[8];
#pragma unroll
        for (int i = 0; i < 8; ++i) rs8[i] = ss[row0 + (i >> 2) * HALF + (i & 3) * 16];
#pragma unroll
        for (int ai = 0; ai < 2; ++ai)
#pragma unroll
            for (int m = 0; m < 4; ++m) { const int row = row0 + ai * HALF + m * 16; const int b = row >> 13, s = row & 8191; const float rs = rstd1024(rs8[ai * 4 + m]);
                const size_t drow = kv ? (size_t)b * 8256 + s : (size_t)row;
                f32x4 x1a = acc[ai][0][m][0] * rs, x1b = acc[ai][0][m][1] * rs, x2a = acc[ai][1][m][0] * rs, x2b = acc[ai][1][m][1] * rs;
                if (do_rope) { const float* rp = rope + (size_t)(16 + s) * 64 + i0;
                    const f32x4 ca = *(const f32x4*)(rp), cb = *(const f32x4*)(rp + 4), sa = *(const f32x4*)(rp + 32), sb = *(const f32x4*)(rp + 36);
                    const f32x4 o1a = (x1a * ca - x2a * sa) * sc, o1b = (x1b * cb - x2b * sb) * sc, o2a = (x2a * ca + x1a * sa) * sc, o2b = (x2b * cb + x1b * sb) * sc;
                    x1a = o1a; x1b = o1b; x2a = o2a; x2b = o2b; }
                u32x4 w1, w2; w1.x = cvt_pk_bf16(x1a[0], x1a[1]); w1.y = cvt_pk_bf16(x1a[2], x1a[3]); w1.z = cvt_pk_bf16(x1b[0], x1b[1]); w1.w = cvt_pk_bf16(x1b[2], x1b[3]);
                w2.x = cvt_pk_bf16(x2a[0], x2a[1]); w2.y = cvt_pk_bf16(x2a[2], x2a[3]); w2.z = cvt_pk_bf16(x2b[0], x2b[1]); w2.w = cvt_pk_bf16(x2b[2], x2b[3]);
                bf16_t* p = dst + drow * ld + col + i0; *(u32x4*)p = w1; *(u32x4*)(p + 32) = w2; }
    }
};

template <class Epi, class Sched, bool ALIGN_EPI = false, bool SP2 = false>
__device__ __forceinline__ void gemm_phase(PG8_LAS unsigned char* lds, const Gemm g, const Sched& S, const Epi& E, const int tid) {
    const int wid = __builtin_amdgcn_readfirstlane(tid >> 6), lane = tid & 63, wr = wid >> 2, wc = wid & 3, fr = lane & 15, fq = lane >> 4;
    const int K = g.K, nt = K / BK;
    unsigned voffA[2], voffB[2];
#pragma unroll
    for (int i = 0; i < 2; ++i) { int R, C; stage_rc(tid * 16 + i * 8192, R, C); const int Rb = Epi::PERM ? ((R & ~31) + perm32(R & 31)) : R;
        voffA[i] = (unsigned)(R * K + C) * 2u; voffB[i] = (unsigned)(Rb * K + C) * 2u; }
    const size_t kstep = (size_t)(BK * 2);
    const size_t hstep = (size_t)HALF * K * 2;
    const size_t tstep = 2 * hstep;
    const unsigned ldsw = (unsigned)wid * 1024u;
    const int aoff = lds_byte(wr * 64 + fr, fq * 8), boff = lds_byte(wc * 32 + fr, fq * 8);
#define PG8_SA(b, h) (((b) * 2 + (h)) * HTB)
#define PG8_SB(b, h) ((4 + (b) * 2 + (h)) * HTB)
#define PG8_STAGE(bufoff, gbase, voff) do { _Pragma("unroll") for (int _i = 0; _i < 2; ++_i) \
        __builtin_amdgcn_global_load_lds((const unsigned*)((const char*)(gbase) + (voff)[_i]), (PG8_LAS unsigned*)(lds + (bufoff) + ldsw + _i * 8192), 16, 0, 0); } while (0)
#define PG8_LDA(dst, b, h) do { _Pragma("unroll") for (int m = 0; m < 4; ++m) _Pragma("unroll") for (int k = 0; k < 2; ++k) dst[m][k] = *(const PG8_LAS bf16x8*)(lds + PG8_SA(b, h) + aoff + m * 2048 + k * 1024); } while (0)
#define PG8_LDB(dst, b, h) do { _Pragma("unroll") for (int n = 0; n < 2; ++n) _Pragma("unroll") for (int k = 0; k < 2; ++k) dst[n][k] = *(const PG8_LAS bf16x8*)(lds + PG8_SB(b, h) + boff + n * 2048 + k * 1024); } while (0)
#define PG8_MMA(ai, bj, At, Bt) do { __builtin_amdgcn_s_setprio(1); _Pragma("unroll") for (int m = 0; m < 4; ++m) _Pragma("unroll") for (int n = 0; n < 2; ++n) _Pragma("unroll") for (int k = 0; k < 2; ++k) \
        acc[ai][bj][m][n] = __builtin_amdgcn_mfma_f32_16x16x32_bf16(Bt[n][k], At[m][k], acc[ai][bj][m][n], 0, 0, 0); __builtin_amdgcn_s_setprio(0); } while (0)
#define PG8_WAIT_V(n) asm volatile("s_waitcnt vmcnt(" #n ")" ::: "memory")
#define PG8_WAIT_L(n) asm volatile("s_waitcnt lgkmcnt(" #n ")" ::: "memory")
#define PG8_BAR __builtin_amdgcn_s_barrier()
#define PG8_SCHED __builtin_amdgcn_sched_barrier(0)
    Unit cur, nxt; int ui = 0;
    if (!S.next(0, cur)) return;
    f32x4 acc[2][2][4][2];
#pragma unroll
    for (int a = 0; a < 2; ++a)
#pragma unroll
        for (int b = 0; b < 2; ++b)
#pragma unroll
            for (int m = 0; m < 4; ++m)
#pragma unroll
                for (int n = 0; n < 2; ++n) acc[a][b][m][n] = (f32x4){0.f, 0.f, 0.f, 0.f};
    bf16x8 At[4][2], B0[2][2], B1[2][2];
    const char* cA = (const char*)g.A + (size_t)cur.pm * tstep; const char* cB = (const char*)g.Bt + (size_t)cur.pn * tstep;
    S.a_ready(cur);
    if constexpr (SP2) {
        PG8_STAGE(PG8_SB(0, 0), cB, voffB); PG8_STAGE(PG8_SB(0, 1), cB + hstep, voffB); PG8_STAGE(PG8_SA(0, 0), cA, voffA); PG8_STAGE(PG8_SA(0, 1), cA + hstep, voffA);
        if (wr == 1) PG8_BAR;
        PG8_WAIT_V(2); PG8_BAR;
        PG8_STAGE(PG8_SB(1, 0), cB + kstep, voffB); PG8_STAGE(PG8_SA(1, 0), cA + kstep, voffA); PG8_STAGE(PG8_SB(1, 1), cB + hstep + kstep, voffB);
        PG8_WAIT_V(6); PG8_BAR;
    } else {
        PG8_STAGE(PG8_SB(0, 0), cB, voffB); PG8_STAGE(PG8_SA(0, 0), cA, voffA); PG8_STAGE(PG8_SB(0, 1), cB + hstep, voffB); PG8_STAGE(PG8_SA(0, 1), cA + hstep, voffA);
        if (wr == 1) PG8_BAR;
        PG8_WAIT_V(4); PG8_BAR;
        PG8_STAGE(PG8_SB(1, 0), cB + kstep, voffB); PG8_STAGE(PG8_SA(1, 0), cA + kstep, voffA); PG8_STAGE(PG8_SB(1, 1), cB + hstep + kstep, voffB);
        PG8_WAIT_V(6); PG8_BAR;
    }
    for (;;) {
        const bool has_next = S.next(ui + 1, nxt);
        const char* nA = has_next ? (const char*)g.A + (size_t)nxt.pm * tstep : cA; const char* nB = has_next ? (const char*)g.Bt + (size_t)nxt.pn * tstep : cB;
        for (int t = 0; t < nt; t += 2) {
            const bool last = (t == nt - 2);
            const char* a1 = cA + (size_t)(t + 1) * kstep;
            const char* a2 = last ? nA : cA + (size_t)(t + 2) * kstep; const char* b2 = last ? nB : cB + (size_t)(t + 2) * kstep;
            const char* a3 = a2 + kstep; const char* b3 = b2 + kstep;
            if (last && has_next) S.a_ready(nxt);
            if constexpr (SP2) {
            PG8_LDB(B0, 0, 0); PG8_LDB(B1, 0, 1); PG8_SCHED; PG8_LDA(At, 0, 0); PG8_STAGE(PG8_SA(1, 1), a1 + hstep, voffA);
            PG8_WAIT_V(8); PG8_WAIT_L(0); PG8_BAR; PG8_MMA(0, 0, At, B0); PG8_MMA(0, 1, At, B1); PG8_BAR; PG8_SCHED;
            PG8_LDA(At, 0, 1); PG8_STAGE(PG8_SB(0, 0), b2, voffB); PG8_STAGE(PG8_SB(0, 1), b2 + hstep, voffB); PG8_STAGE(PG8_SA(0, 0), a2, voffA);
            PG8_WAIT_V(8); PG8_WAIT_L(0); PG8_BAR; PG8_MMA(1, 0, At, B0); PG8_MMA(1, 1, At, B1); PG8_BAR; PG8_SCHED;
            PG8_LDB(B0, 1, 0); PG8_LDB(B1, 1, 1); PG8_SCHED; PG8_LDA(At, 1, 0); PG8_STAGE(PG8_SA(0, 1), a2 + hstep, voffA);
            PG8_WAIT_V(8); PG8_WAIT_L(0); PG8_BAR; PG8_MMA(0, 0, At, B0); PG8_MMA(0, 1, At, B1); PG8_BAR; PG8_SCHED;
            PG8_LDA(At, 1, 1); PG8_STAGE(PG8_SB(1, 0), b3, voffB); PG8_STAGE(PG8_SB(1, 1), b3 + hstep, voffB); PG8_STAGE(PG8_SA(1, 0), a3, voffA);
            PG8_WAIT_V(8); PG8_WAIT_L(0); PG8_BAR; PG8_MMA(1, 0, At, B0); PG8_MMA(1, 1, At, B1); PG8_BAR; PG8_SCHED;
            } else {
            PG8_LDB(B0, 0, 0); PG8_SCHED; PG8_LDA(At, 0, 0); PG8_STAGE(PG8_SA(1, 1), a1 + hstep, voffA);
            PG8_WAIT_L(8); PG8_BAR; PG8_WAIT_L(0); PG8_MMA(0, 0, At, B0); PG8_BAR; PG8_SCHED;
            PG8_LDB(B1, 0, 1); PG8_STAGE(PG8_SB(0, 0), b2, voffB);
            PG8_BAR; PG8_WAIT_L(0); PG8_MMA(0, 1, At, B1); PG8_BAR;
            PG8_LDA(At, 0, 1); PG8_STAGE(PG8_SA(0, 0), a2, voffA);
            PG8_BAR; PG8_WAIT_L(0); PG8_MMA(1, 0, At, B0); PG8_BAR; PG8_SCHED;
            PG8_STAGE(PG8_SB(0, 1), b2 + hstep, voffB);
            PG8_WAIT_V(6); PG8_BAR; PG8_MMA(1, 1, At, B1); PG8_BAR;
            PG8_LDB(B0, 1, 0); PG8_SCHED; PG8_LDA(At, 1, 0); PG8_STAGE(PG8_SA(0, 1), a2 + hstep, voffA);
            PG8_WAIT_L(8); PG8_BAR; PG8_WAIT_L(0); PG8_MMA(0, 0, At, B0); PG8_BAR; PG8_SCHED;
            PG8_LDB(B1, 1, 1); PG8_STAGE(PG8_SB(1, 0), b3, voffB);
            PG8_BAR; PG8_WAIT_L(0); PG8_MMA(0, 1, At, B1); PG8_BAR;
            PG8_LDA(At, 1, 1); PG8_STAGE(PG8_SA(1, 0), a3, voffA);
            PG8_BAR; PG8_WAIT_L(0); PG8_MMA(1, 0, At, B0); PG8_BAR; PG8_SCHED;
            PG8_STAGE(PG8_SB(1, 1), b3 + hstep, voffB);
            PG8_WAIT_V(6); PG8_BAR; PG8_MMA(1, 1, At, B1); PG8_BAR;
            }
        }
        if constexpr (ALIGN_EPI) { if (wr == 0) PG8_BAR; }
        if constexpr (!Epi::AFTER_DRAIN) { E(acc, cur, wr, wc, fr, fq); S.done(cur); }
        if (!has_next) break;
#pragma unroll
        for (int a = 0; a < 2; ++a)
#pragma unroll
            for (int b = 0; b < 2; ++b)
#pragma unroll
                for (int m = 0; m < 4; ++m)
#pragma unroll
                    for (int n = 0; n < 2; ++n) acc[a][b][m][n] = (f32x4){0.f, 0.f, 0.f, 0.f};
        cur = nxt; cA = nA; cB = nB; ++ui;
        if constexpr (ALIGN_EPI) { if (wr == 1) PG8_BAR; }
    }
    PG8_WAIT_V(0);
    if constexpr (!ALIGN_EPI) { if (wr == 0) PG8_BAR; }
    PG8_BAR;
    if constexpr (Epi::AFTER_DRAIN) { E.fused(acc, cur, wr, wc, fr, fq, lds, wid, lane); S.done(cur); }
#undef PG8_SA
#undef PG8_SB
#undef PG8_STAGE
#undef PG8_LDA
#undef PG8_LDB
#undef PG8_MMA
#undef PG8_WAIT_V
#undef PG8_WAIT_L
#undef PG8_BAR
#undef PG8_SCHED
}
}
namespace att {
#define ATT_LAS __attribute__((address_space(3)))
typedef unsigned short bf16_t;
typedef short bf16x8 __attribute__((ext_vector_type(8)));
typedef short s16x4 __attribute__((ext_vector_type(4)));
typedef float f32x16 __attribute__((ext_vector_type(16)));
typedef unsigned u32x4 __attribute__((ext_vector_type(4)));
typedef float f32x2_t __attribute__((ext_vector_type(2))); typedef __bf16 bf16x2_t __attribute__((ext_vector_type(2)));
#define SBAR() __builtin_amdgcn_sched_barrier(0)
__device__ __forceinline__ int crow(int r, int hi) { return (r & 3) + 8 * (r >> 2) + 4 * hi; }
__device__ __forceinline__ unsigned cvtpk_s(float lo, float hi) { f32x2_t v = {lo, hi}; bf16x2_t b = __builtin_convertvector(v, bf16x2_t); return __builtin_bit_cast(unsigned, b); }
__device__ __forceinline__ float bf_lo(unsigned w) { return __uint_as_float(w << 16); }
__device__ __forceinline__ float bf_hi(unsigned w) { return __uint_as_float(w & 0xffff0000u); }
typedef ATT_LAS const char* lds_cptr;
typedef ATT_LAS char* lds_ptr;
__device__ __forceinline__ void qkt(f32x16& p0, f32x16& p1, lds_cptr Kslot, const bf16x8* qr, int r32, int hi) {
    const f32x16 negm = {0.f,0.f,0.f,0.f,0.f,0.f,0.f,0.f,0.f,0.f,0.f,0.f,0.f,0.f,0.f,0.f};
    lds_cptr kb = Kslot + hi * 1024 + r32 * 16;
#pragma unroll
    for (int d0 = 0; d0 < 4; ++d0) {
        const bf16x8 b0 = *(const ATT_LAS bf16x8*)(kb + d0 * 2048);
        const bf16x8 b1 = *(const ATT_LAS bf16x8*)(kb + d0 * 2048 + 512);
        if (d0 == 0) { p0 = __builtin_amdgcn_mfma_f32_32x32x16_bf16(b0, qr[0], negm, 0, 0, 0); p1 = __builtin_amdgcn_mfma_f32_32x32x16_bf16(b1, qr[0], negm, 0, 0, 0); }
        else { p0 = __builtin_amdgcn_mfma_f32_32x32x16_bf16(b0, qr[d0], p0, 0, 0, 0); p1 = __builtin_amdgcn_mfma_f32_32x32x16_bf16(b1, qr[d0], p1, 0, 0, 0); } }
}
__device__ __forceinline__ float rowmax(const f32x16& p0, const f32x16& p1) {
    float a = __builtin_fmaxf(p0[0], p1[0]), b = __builtin_fmaxf(p0[1], p1[1]);
#pragma unroll
    for (int r = 2; r < 16; r += 2) { a = __builtin_fmaxf(a, __builtin_fmaxf(p0[r], p1[r])); b = __builtin_fmaxf(b, __builtin_fmaxf(p0[r + 1], p1[r + 1])); }
    const float m = __builtin_fmaxf(a, b);
    return __builtin_fmaxf(m, __shfl_xor(m, 32));
}
__device__ __forceinline__ float max3f(float a, float b, float c) { float r; asm("v_max3_f32 %0, %1, %2, %3" : "=v"(r) : "v"(a), "v"(b), "v"(c)); return r; }
__device__ __forceinline__ float max2f(float a, float b) { float r; asm("v_max_f32_e32 %0, %1, %2" : "=v"(r) : "v"(a), "v"(b)); return r; }
__device__ __forceinline__ float rowmax_fast(const f32x16& p0, const f32x16& p1) {
    float a = max3f(p0[0], p0[1], p1[0]), b = max3f(p0[2], p0[3], p1[1]); a = max3f(a, p1[2], p1[3]);
#pragma unroll
    for (int r = 4; r < 16; r += 4) { a = max3f(a, p0[r], p0[r + 1]); b = max3f(b, p0[r + 2], p0[r + 3]); a = max3f(a, p1[r], p1[r + 1]); b = max3f(b, p1[r + 2], p1[r + 3]); }
    const float m = max2f(a, b);
    auto rr = __builtin_amdgcn_permlane32_swap(__float_as_uint(m), __float_as_uint(m), false, false);
    return max2f(__uint_as_float(rr[0]), __uint_as_float(rr[1]));
}
template <int NDQ> __device__ __forceinline__ void pv(f32x16* o, int vb, bf16x8 pa0, bf16x8 pa1, bf16x8 pa2, bf16x8 pa3) {
#pragma unroll
    for (int d0 = 0; d0 < NDQ; ++d0) { s16x4 lo[4], hi[4];
#pragma unroll
        for (int ks = 0; ks < 4; ++ks) {
            asm volatile("ds_read_b64_tr_b16 %0,%1 offset:%c2" : "=&v"(lo[ks]) : "v"(vb), "i"(d0 * 4096 + ks * 1024) : "memory");
            asm volatile("ds_read_b64_tr_b16 %0,%1 offset:%c2" : "=&v"(hi[ks]) : "v"(vb), "i"(d0 * 4096 + ks * 1024 + 512) : "memory"); }
        asm volatile("s_waitcnt lgkmcnt(0)" ::: "memory"); SBAR();
#define ATT_PK(k) (bf16x8){lo[k][0], lo[k][1], lo[k][2], lo[k][3], hi[k][0], hi[k][1], hi[k][2], hi[k][3]}
        o[d0] = __builtin_amdgcn_mfma_f32_32x32x16_bf16(pa0, ATT_PK(0), o[d0], 0, 0, 0);
        o[d0] = __builtin_amdgcn_mfma_f32_32x32x16_bf16(pa1, ATT_PK(1), o[d0], 0, 0, 0);
        o[d0] = __builtin_amdgcn_mfma_f32_32x32x16_bf16(pa2, ATT_PK(2), o[d0], 0, 0, 0);
        o[d0] = __builtin_amdgcn_mfma_f32_32x32x16_bf16(pa3, ATT_PK(3), o[d0], 0, 0, 0);
#undef ATT_PK
    }
}
template <int NDQ> __device__ __forceinline__ void softmax_pv(f32x16& p0, f32x16& p1, float& mref, float& l, f32x16* o, int vb, int r32, ATT_LAS float* wsf, const ATT_LAS float* wsh) {
    const float rm = rowmax_fast(p0, p1) - mref;
    if (__any(rm > 8.0f)) {
        const float dl = __builtin_fmaxf(rm, 0.f); mref += dl;
        const float f = __builtin_amdgcn_exp2f(-dl); l *= f;
        wsf[r32] = f;
#pragma unroll
        for (int r = 0; r < 16; ++r) { const float fr_ = wsh[(r & 3) + 8 * (r >> 2)];
#pragma unroll
            for (int d = 0; d < NDQ; ++d) o[d][r] *= fr_; }
    }
    float s0 = 0.f, s1 = 0.f;
#pragma unroll
    for (int r = 0; r < 16; ++r) { p0[r] = __builtin_amdgcn_exp2f(p0[r] - mref); p1[r] = __builtin_amdgcn_exp2f(p1[r] - mref); s0 += p0[r]; s1 += p1[r]; }
    l += s0 + s1;
    u32x4 pw0, pw1, pw2, pw3;
    pw0 = (u32x4){cvtpk_s(p0[0], p0[1]), cvtpk_s(p0[2], p0[3]), cvtpk_s(p0[4], p0[5]), cvtpk_s(p0[6], p0[7])};
    pw1 = (u32x4){cvtpk_s(p0[8], p0[9]), cvtpk_s(p0[10], p0[11]), cvtpk_s(p0[12], p0[13]), cvtpk_s(p0[14], p0[15])};
    pw2 = (u32x4){cvtpk_s(p1[0], p1[1]), cvtpk_s(p1[2], p1[3]), cvtpk_s(p1[4], p1[5]), cvtpk_s(p1[6], p1[7])};
    pw3 = (u32x4){cvtpk_s(p1[8], p1[9]), cvtpk_s(p1[10], p1[11]), cvtpk_s(p1[12], p1[13]), cvtpk_s(p1[14], p1[15])};
    SBAR();
    pv<NDQ>(o, vb, __builtin_bit_cast(bf16x8, pw0), __builtin_bit_cast(bf16x8, pw1), __builtin_bit_cast(bf16x8, pw2), __builtin_bit_cast(bf16x8, pw3));
}
__device__ __forceinline__ f32x16 splat16(float v) { f32x16 x;
#pragma unroll
    for (int r = 0; r < 16; ++r) x[r] = v; return x; }
constexpr int KVROWS = 8256, NREAL = 8192, NKT = 129;
constexpr float NEG_INF = -__builtin_inff();

#ifndef ATT_NEGM
#define ATT_NEGM 0
#endif
#ifndef ATT_PVF
#define ATT_PVF pv2
#endif
template <int NDQ> __device__ __forceinline__ void pv2(f32x16* o, int vb, bf16x8 pa0, bf16x8 pa1, bf16x8 pa2, bf16x8 pa3) {
    s16x4 lo[2][4], hi[2][4];
#define ATT_RD(S, D) do { _Pragma("unroll") for (int ks = 0; ks < 4; ++ks) { \
        asm volatile("ds_read_b64_tr_b16 %0,%1 offset:%c2" : "=&v"(lo[S][ks]) : "v"(vb), "i"((D) * 4096 + ks * 1024) : "memory"); \
        asm volatile("ds_read_b64_tr_b16 %0,%1 offset:%c2" : "=&v"(hi[S][ks]) : "v"(vb), "i"((D) * 4096 + ks * 1024 + 512) : "memory"); } } while (0)
#define ATT_PK2(S, k) (bf16x8){lo[S][k][0], lo[S][k][1], lo[S][k][2], lo[S][k][3], hi[S][k][0], hi[S][k][1], hi[S][k][2], hi[S][k][3]}
    ATT_RD(0, 0);
#pragma unroll
    for (int d0 = 0; d0 < NDQ; ++d0) {
        if (d0 + 1 < NDQ) { if ((d0 & 1) == 0) ATT_RD(1, d0 + 1); else ATT_RD(0, d0 + 1); asm volatile("s_waitcnt lgkmcnt(8)" ::: "memory"); }
        else asm volatile("s_waitcnt lgkmcnt(0)" ::: "memory");
        SBAR();
        if ((d0 & 1) == 0) {
            o[d0] = __builtin_amdgcn_mfma_f32_32x32x16_bf16(pa0, ATT_PK2(0, 0), o[d0], 0, 0, 0); o[d0] = __builtin_amdgcn_mfma_f32_32x32x16_bf16(pa1, ATT_PK2(0, 1), o[d0], 0, 0, 0);
            o[d0] = __builtin_amdgcn_mfma_f32_32x32x16_bf16(pa2, ATT_PK2(0, 2), o[d0], 0, 0, 0); o[d0] = __builtin_amdgcn_mfma_f32_32x32x16_bf16(pa3, ATT_PK2(0, 3), o[d0], 0, 0, 0);
        } else {
            o[d0] = __builtin_amdgcn_mfma_f32_32x32x16_bf16(pa0, ATT_PK2(1, 0), o[d0], 0, 0, 0); o[d0] = __builtin_amdgcn_mfma_f32_32x32x16_bf16(pa1, ATT_PK2(1, 1), o[d0], 0, 0, 0);
            o[d0] = __builtin_amdgcn_mfma_f32_32x32x16_bf16(pa2, ATT_PK2(1, 2), o[d0], 0, 0, 0); o[d0] = __builtin_amdgcn_mfma_f32_32x32x16_bf16(pa3, ATT_PK2(1, 3), o[d0], 0, 0, 0);
        }
        SBAR();
    }
#undef ATT_RD
#undef ATT_PK2
}
struct VFrag { s16x4 lo[2][4], hi[2][4]; };
#define ATT_RDF(F, S, D) do { _Pragma("unroll") for (int ks = 0; ks < 4; ++ks) { \
        asm volatile("ds_read_b64_tr_b16 %0,%1 offset:%c2" : "=&v"(F.lo[S][ks]) : "v"(vb), "i"((D) * 4096 + ks * 1024) : "memory"); \
        asm volatile("ds_read_b64_tr_b16 %0,%1 offset:%c2" : "=&v"(F.hi[S][ks]) : "v"(vb), "i"((D) * 4096 + ks * 1024 + 512) : "memory"); } } while (0)
#define ATT_PKF(F, S, k) (bf16x8){F.lo[S][k][0], F.lo[S][k][1], F.lo[S][k][2], F.lo[S][k][3], F.hi[S][k][0], F.hi[S][k][1], F.hi[S][k][2], F.hi[S][k][3]}
__device__ __forceinline__ void pv4_issue0(VFrag& F, int vb) { ATT_RDF(F, 0, 0); }
__device__ __forceinline__ void pv4_rest(VFrag& F, f32x16* o, int vb, bf16x8 pa0, bf16x8 pa1, bf16x8 pa2, bf16x8 pa3) {
#pragma unroll
    for (int d0 = 0; d0 < 4; ++d0) {
        if (d0 + 1 < 4) { if ((d0 & 1) == 0) ATT_RDF(F, 1, d0 + 1); else ATT_RDF(F, 0, d0 + 1); asm volatile("s_waitcnt lgkmcnt(8)" ::: "memory"); }
        else asm volatile("s_waitcnt lgkmcnt(0)" ::: "memory");
        SBAR();
        if ((d0 & 1) == 0) {
            o[d0] = __builtin_amdgcn_mfma_f32_32x32x16_bf16(pa0, ATT_PKF(F, 0, 0), o[d0], 0, 0, 0); o[d0] = __builtin_amdgcn_mfma_f32_32x32x16_bf16(pa1, ATT_PKF(F, 0, 1), o[d0], 0, 0, 0);
            o[d0] = __builtin_amdgcn_mfma_f32_32x32x16_bf16(pa2, ATT_PKF(F, 0, 2), o[d0], 0, 0, 0); o[d0] = __builtin_amdgcn_mfma_f32_32x32x16_bf16(pa3, ATT_PKF(F, 0, 3), o[d0], 0, 0, 0);
        } else {
            o[d0] = __builtin_amdgcn_mfma_f32_32x32x16_bf16(pa0, ATT_PKF(F, 1, 0), o[d0], 0, 0, 0); o[d0] = __builtin_amdgcn_mfma_f32_32x32x16_bf16(pa1, ATT_PKF(F, 1, 1), o[d0], 0, 0, 0);
            o[d0] = __builtin_amdgcn_mfma_f32_32x32x16_bf16(pa2, ATT_PKF(F, 1, 2), o[d0], 0, 0, 0); o[d0] = __builtin_amdgcn_mfma_f32_32x32x16_bf16(pa3, ATT_PKF(F, 1, 3), o[d0], 0, 0, 0);
        }
        SBAR();
    }
}
__device__ __forceinline__ void qkt_c(f32x16& p0, f32x16& p1, lds_cptr Kslot, const bf16x8* qr, const f32x16& negm, int r32, int hi) {
    lds_cptr kb = Kslot + hi * 1024 + r32 * 16;
#pragma unroll
    for (int d0 = 0; d0 < 4; ++d0) {
        const bf16x8 b0 = *(const ATT_LAS bf16x8*)(kb + d0 * 2048);
        const bf16x8 b1 = *(const ATT_LAS bf16x8*)(kb + d0 * 2048 + 512);
        if (d0 == 0) { p0 = __builtin_amdgcn_mfma_f32_32x32x16_bf16(b0, qr[0], negm, 0, 0, 0); p1 = __builtin_amdgcn_mfma_f32_32x32x16_bf16(b1, qr[0], negm, 0, 0, 0); }
        else { p0 = __builtin_amdgcn_mfma_f32_32x32x16_bf16(b0, qr[d0], p0, 0, 0, 0); p1 = __builtin_amdgcn_mfma_f32_32x32x16_bf16(b1, qr[d0], p1, 0, 0, 0); } }
}
__device__ __forceinline__ void kload8(bf16x8* kf, lds_cptr kp) {
#pragma unroll
    for (int d0 = 0; d0 < 4; ++d0) { kf[2 * d0] = *(const ATT_LAS bf16x8*)(kp + d0 * 2048); kf[2 * d0 + 1] = *(const ATT_LAS bf16x8*)(kp + d0 * 2048 + 512); }
}
__device__ __forceinline__ void qk_held(f32x16& p0, f32x16& p1, const bf16x8* kf, const bf16x8* qr) {
    const f32x16 z = {0.f,0.f,0.f,0.f,0.f,0.f,0.f,0.f,0.f,0.f,0.f,0.f,0.f,0.f,0.f,0.f};
    p0 = __builtin_amdgcn_mfma_f32_32x32x16_bf16(kf[0], qr[0], z, 0, 0, 0); p1 = __builtin_amdgcn_mfma_f32_32x32x16_bf16(kf[1], qr[0], z, 0, 0, 0);
#pragma unroll
    for (int d0 = 1; d0 < 4; ++d0) { p0 = __builtin_amdgcn_mfma_f32_32x32x16_bf16(kf[2 * d0], qr[d0], p0, 0, 0, 0); p1 = __builtin_amdgcn_mfma_f32_32x32x16_bf16(kf[2 * d0 + 1], qr[d0], p1, 0, 0, 0); }
}
__device__ __forceinline__ void glds16(const void* gsrc, unsigned lds_dst) { unsigned keep;
    asm volatile("s_mov_b32 %0, m0\n\ts_mov_b32 m0, %2\n\ts_nop 0\n\tglobal_load_lds_dwordx4 %1, off\n\ts_mov_b32 m0, %0" : "=&s"(keep) : "v"(gsrc), "s"(lds_dst) : "memory"); }
__device__ __forceinline__ void diff_unit(int b, int h, int qb, const bf16_t* QA, const bf16_t* KA, const bf16_t* VA, bf16_t* ATT, float lam, lds_ptr lds, unsigned lds0, const int tid) {
    const int lane = tid & 63, r32 = lane & 31, hi = lane >> 5; const int wid = __builtin_amdgcn_readfirstlane(tid >> 6);
    const int grp = wid >> 2;
    const size_t m0 = (size_t)b * NREAL + (size_t)qb * 256 + wid * 32; const size_t kv0 = (size_t)b * KVROWS;
    const int vlane = ((lane >> 4) & 1) * 32 + (lane & 3) * 8 + (4 * hi + ((lane & 15) >> 2)) * 64;
    ATT_LAS float* wsf = (ATT_LAS float*)(lds + 131072 + wid * 256); const ATT_LAS float* wsh = wsf + 4 * hi;
#pragma unroll 1
    for (int c = 0; c < 2; ++c) {
        const int ch = h * 2 + c;
        bf16x8 qr[4];
#pragma unroll
        for (int d0 = 0; d0 < 4; ++d0) qr[d0] = *(const bf16x8*)(QA + m0 * 512 + ch * 64 + ((unsigned)r32 * 512u + (unsigned)hi * 8u + d0 * 16));
        const bf16_t* ksrc_u = KA + kv0 * 512 + ch * 64 + wid * 8; const unsigned koff = (unsigned)lane * 512u;
        const bf16_t* vsrc_u = VA + (kv0 + (wid & 3) * 16) * 512 + h * 128 + (wid >> 2) * 32; const unsigned voff = (unsigned)(lane >> 2) * 512u + (unsigned)(lane & 3) * 8u;
#define DMA_K(T) glds16(ksrc_u + koff + (size_t)(T) * 64 * 512, (unsigned)__builtin_amdgcn_readfirstlane(lds0 + (unsigned)(((T) & 3) * 8192 + wid * 1024)))
#define DMA_V(T) do { const bf16_t* vp_ = vsrc_u + voff + (size_t)(T) * 64 * 512; const unsigned vd_ = lds0 + (unsigned)(32768 + ((T) & 3) * 16384 + wid * 1024); \
            glds16(vp_, (unsigned)__builtin_amdgcn_readfirstlane(vd_)); glds16(vp_ + 64, (unsigned)__builtin_amdgcn_readfirstlane(vd_ + 8192u)); } while (0)
        DMA_K(0); DMA_V(0); DMA_K(1); DMA_V(1); DMA_K(2); DMA_V(2); DMA_K(3);
        asm volatile("s_waitcnt vmcnt(0) lgkmcnt(0)\n\ts_barrier" ::: "memory");
        f32x16 o[4];
#pragma unroll
        for (int d = 0; d < 4; ++d) o[d] = splat16(0.f);
        float mref = 0.f, l = 0.f; f32x16 negm = splat16(0.f); asm volatile("" : "+v"(negm));
        f32x16 p0, p1; u32x4 pw0 = {0u, 0u, 0u, 0u}, pw1 = pw0, pw2 = pw0, pw3 = pw0;
        qkt(p0, p1, (lds_cptr)lds, qr, r32, hi); asm volatile("s_nop 15\n\ts_nop 15" : "+v"(p0), "+v"(p1));
        { const float rm0 = rowmax_fast(p0, p1); mref = rm0;
#pragma unroll
          for (int r = 0; r < 16; ++r) { p0[r] -= rm0; p1[r] -= rm0; }
          negm = splat16(-mref); asm volatile("" : "+v"(negm)); }
#define DIFF_X(T, MASK) do { \
            if (MASK) { _Pragma("unroll") for (int r = 0; r < 16; ++r) { if (r >= 8) p0[r] = NEG_INF; p1[r] = NEG_INF; } } \
            const float rm = rowmax_fast(p0, p1); \
            if (__any(rm > 8.0f)) { const float dl = __builtin_fmaxf(rm, 0.f); mref += dl; \
                _Pragma("unroll") for (int r = 0; r < 16; ++r) { p0[r] -= dl; p1[r] -= dl; } \
                negm = splat16(-mref); asm volatile("" : "+v"(negm)); \
                const float f = __builtin_amdgcn_exp2f(-dl); l *= f; wsf[r32] = f; \
                _Pragma("unroll") for (int r = 0; r < 16; ++r) { const float fr_ = wsh[(r & 3) + 8 * (r >> 2)]; _Pragma("unroll") for (int d = 0; d < 4; ++d) o[d][r] *= fr_; } } \
            float s0 = 0.f, s1 = 0.f; \
            _Pragma("unroll") for (int r = 0; r < 16; ++r) { p0[r] = __builtin_amdgcn_exp2f(p0[r]); p1[r] = __builtin_amdgcn_exp2f(p1[r]); s0 += p0[r]; s1 += p1[r]; } \
            l += s0 + s1; \
            pw0 = (u32x4){cvtpk_s(p0[0], p0[1]), cvtpk_s(p0[2], p0[3]), cvtpk_s(p0[4], p0[5]), cvtpk_s(p0[6], p0[7])}; \
            pw1 = (u32x4){cvtpk_s(p0[8], p0[9]), cvtpk_s(p0[10], p0[11]), cvtpk_s(p0[12], p0[13]), cvtpk_s(p0[14], p0[15])}; \
            pw2 = (u32x4){cvtpk_s(p1[0], p1[1]), cvtpk_s(p1[2], p1[3]), cvtpk_s(p1[4], p1[5]), cvtpk_s(p1[6], p1[7])}; \
            pw3 = (u32x4){cvtpk_s(p1[8], p1[9]), cvtpk_s(p1[10], p1[11]), cvtpk_s(p1[12], p1[13]), cvtpk_s(p1[14], p1[15])}; } while (0)
#define DIFF_Y(T) do { VFrag vf_; const int vb_ = (int)(lds0 + 32768 + ((T) & 3) * 16384) + vlane; \
            pv4_issue0(vf_, vb_); \
            const bf16x8 pa0_ = __builtin_bit_cast(bf16x8, pw0), pa1_ = __builtin_bit_cast(bf16x8, pw1), pa2_ = __builtin_bit_cast(bf16x8, pw2), pa3_ = __builtin_bit_cast(bf16x8, pw3); \
            if ((T) + 1 < NKT) { qkt_c(p0, p1, (lds_cptr)(lds + (((T) + 1) & 3) * 8192), qr, negm, r32, hi); } \
            SBAR(); \
            pv4_rest(vf_, o, vb_, pa0_, pa1_, pa2_, pa3_); \
            asm volatile("s_nop 7" : "+v"(p0), "+v"(p1)); } while (0)
#define DIFF_STAGE(T) do { if ((T) + 4 < NKT) DMA_K((T) + 4); if ((T) + 3 < NKT) DMA_V((T) + 3); } while (0)
#define DIFF_BARV(T) do { if ((T) + 6 < NKT) asm volatile("s_waitcnt vmcnt(6) lgkmcnt(0)\n\ts_barrier" ::: "memory"); else asm volatile("s_waitcnt vmcnt(0) lgkmcnt(0)\n\ts_barrier" ::: "memory"); } while (0)
#define DIFF_PINX() asm volatile("" : "+v"(pw0), "+v"(pw1), "+v"(pw2), "+v"(pw3), "+v"(l))
#pragma unroll 1
        for (int t = 0; t < NKT - 1; ++t) {
            if (grp == 1) { DIFF_BARV(t); DIFF_STAGE(t); }
            DIFF_X(t, false);
            DIFF_PINX();
            if (grp == 0) { DIFF_BARV(t); }
            DIFF_Y(t);
            if (grp == 0) { DIFF_STAGE(t); }
        }
        {
            if (grp == 1) DIFF_BARV(NKT - 1);
            DIFF_X(NKT - 1, true);
            DIFF_PINX();
            if (grp == 0) DIFF_BARV(NKT - 1);
            DIFF_Y(NKT - 1);
        }
        asm volatile("s_waitcnt vmcnt(0) lgkmcnt(0)\n\ts_barrier" ::: "memory");
#undef DIFF_BARV
#undef DIFF_PINX
#undef DIFF_STAGE
#undef DIFF_X
#undef DIFF_Y
#undef DMA_K
#undef DMA_V
        const float lt = l + __shfl_xor(l, 32); const float il = 1.0f / lt;
        wsf[r32] = il;
        __hip_bfloat16* obase = (__hip_bfloat16*)ATT + (m0 + 4 * hi) * 1024 + h * 128 + r32; asm volatile("" : "+v"(obase));
        if (c == 0) {
#pragma unroll
            for (int r = 0; r < 16; ++r) { const float rl = wsh[(r & 3) + 8 * (r >> 2)]; __hip_bfloat16* orow = obase + (size_t)((r & 3) + 8 * (r >> 2)) * 1024;
#pragma unroll
                for (int d = 0; d < 4; ++d) orow[d * 32] = __float2bfloat16(o[d][r] * rl); }
        } else {
#pragma unroll
            for (int r = 0; r < 16; ++r) { const float rl = wsh[(r & 3) + 8 * (r >> 2)]; float q = 0.f; __hip_bfloat16* orow = obase + (size_t)((r & 3) + 8 * (r >> 2)) * 1024;
#pragma unroll
                for (int d = 0; d < 4; ++d) { const float a0 = __bfloat162float(orow[d * 32]); const float v = a0 - lam * (o[d][r] * rl); o[d][r] = v; q += v * v; }
                q += __shfl_xor(q, 1); q += __shfl_xor(q, 2); q += __shfl_xor(q, 4); q += __shfl_xor(q, 8); q += __shfl_xor(q, 16);
                const float rs = __builtin_amdgcn_rsqf(q * (1.0f / 128.0f) + 1e-6f);
#pragma unroll
                for (int d = 0; d < 4; ++d) orow[d * 32] = __float2bfloat16(o[d][r] * rs); }
        }
    }
}

__device__ __forceinline__ void win_unit(int b, int qb, const bf16_t* QBW, const bf16_t* KB, const bf16_t* VB, bf16_t* ATT, const float* sink, lds_ptr lds, unsigned lds0, const int tid) {
    const int lane = tid & 63, r32 = lane & 31, hi = lane >> 5; const int wid = __builtin_amdgcn_readfirstlane(tid >> 6);
    const int hq = wid, hk = wid >> 2; const int q0 = qb * 32; const size_t m0 = (size_t)b * NREAL + q0; const size_t kv0 = (size_t)b * KVROWS;
    const int vlane = ((lane >> 4) & 1) * 32 + (lane & 3) * 8 + (4 * hi + ((lane & 15) >> 2)) * 64;
    ATT_LAS float* wsf = (ATT_LAS float*)(lds + 131072 + wid * 256); const ATT_LAS float* wsh = wsf + 4 * hi;
    bf16x8 qr[4];
#pragma unroll
    for (int d0 = 0; d0 < 4; ++d0) qr[d0] = *(const bf16x8*)(QBW + m0 * 512 + hq * 64 + ((unsigned)r32 * 512u + (unsigned)hi * 8u + d0 * 16));
    f32x16 o[2]; o[0] = splat16(0.f); o[1] = splat16(0.f);
    float mref = 0.f, l = (hi == 0) ? __builtin_amdgcn_exp2f(sink[hq] * 1.4426950408889634f) : 0.f;
    int jlo = (q0 - 128) >> 6; if (jlo < 0) jlo = 0; int jhi = (q0 + 31 + 128) >> 6; if (jhi > 127) jhi = 127; const int nt = jhi - jlo + 2;
    const bf16_t* ksrc_u = KB + kv0 * 128 + wid * 8; const unsigned koff = (unsigned)lane * 128u;
    const bf16_t* vsrc_u = VB + (kv0 + (wid & 3) * 16) * 128 + (wid >> 2) * 32; const unsigned voff = (unsigned)(lane >> 2) * 128u + (unsigned)(lane & 3) * 8u;
#define ksrc (ksrc_u + koff)
#define vsrc (vsrc_u + voff)
    u32x4 k0r, k1r, v0r, v1r;
    { const size_t adv = (size_t)jlo * 64 * 128; k0r = *(const u32x4*)(ksrc + adv); k1r = *(const u32x4*)(ksrc + adv + 64); v0r = *(const u32x4*)(vsrc + adv); v1r = *(const u32x4*)(vsrc + adv + 64); }
    *(ATT_LAS u32x4*)(lds + wid * 1024 + lane * 16) = k0r; *(ATT_LAS u32x4*)(lds + 8192 + wid * 1024 + lane * 16) = k1r;
    *(ATT_LAS u32x4*)(lds + 16384 + tid * 16) = v0r; *(ATT_LAS u32x4*)(lds + 24576 + tid * 16) = v1r;
    __syncthreads();
#pragma unroll 1
    for (int i = 0; i < nt; ++i) {
        const int j = (i < nt - 1) ? jlo + i : 128; const int buf = i & 1;
        if (i + 1 < nt) { const int jn = (i + 1 < nt - 1) ? jlo + i + 1 : 128; const size_t adv = (size_t)jn * 64 * 128;
            k0r = *(const u32x4*)(ksrc + adv); k1r = *(const u32x4*)(ksrc + adv + 64); v0r = *(const u32x4*)(vsrc + adv); v1r = *(const u32x4*)(vsrc + adv + 64); }
        { f32x16 p0, p1;
            qkt(p0, p1, (lds_cptr)(lds + buf * 32768 + hk * 8192), qr, r32, hi); asm volatile("s_nop 15\n\ts_nop 15" : "+v"(p0), "+v"(p1));
            if (j == 128) {
#pragma unroll
                for (int r = 0; r < 16; ++r) { if (r >= 8) p0[r] = NEG_INF; p1[r] = NEG_INF; }
            } else if (!(64 * j + 63 <= q0 + 128 && 64 * j >= q0 - 97)) { const int dq = 64 * j - (q0 + r32);
#pragma unroll
                for (int r = 0; r < 16; ++r) { const int d0_ = dq + crow(r, hi), d1_ = d0_ + 32;
                    if (d0_ > 128 || d0_ < -128) p0[r] = NEG_INF; if (d1_ > 128 || d1_ < -128) p1[r] = NEG_INF; } }
            softmax_pv<2>(p0, p1, mref, l, o, (int)(lds0 + buf * 32768 + 16384 + hk * 8192) + vlane, r32, wsf, wsh);
        }
        if (i + 1 < nt) { const int nb = buf ^ 1;
            *(ATT_LAS u32x4*)(lds + nb * 32768 + wid * 1024 + lane * 16) = k0r; *(ATT_LAS u32x4*)(lds + nb * 32768 + 8192 + wid * 1024 + lane * 16) = k1r;
            *(ATT_LAS u32x4*)(lds + nb * 32768 + 16384 + tid * 16) = v0r; *(ATT_LAS u32x4*)(lds + nb * 32768 + 24576 + tid * 16) = v1r; }
        __syncthreads();
    }
#undef ksrc
#undef vsrc
    ATT_LAS float* ssx = (ATT_LAS float*)(lds + 65536);
    { const float lt = l + __shfl_xor(l, 32); const float il = 1.0f / lt;
        wsf[r32] = il;
#pragma unroll
        for (int r = 0; r < 16; ++r) { const float rl = wsh[(r & 3) + 8 * (r >> 2)]; o[0][r] *= rl; o[1][r] *= rl;
            float q = o[0][r] * o[0][r] + o[1][r] * o[1][r];
            q += __shfl_xor(q, 1); q += __shfl_xor(q, 2); q += __shfl_xor(q, 4); q += __shfl_xor(q, 8); q += __shfl_xor(q, 16);
            if (r32 == 0) ssx[wid * 32 + crow(r, hi)] = q; } }
    __syncthreads();
    __hip_bfloat16* wbase = (__hip_bfloat16*)ATT + (m0 + 4 * hi) * 1024 + 512 + hq * 64 + r32; asm volatile("" : "+v"(wbase));
#pragma unroll
    for (int r = 0; r < 16; ++r) { const int rr = crow(r, hi); float tot = 0.f;
#pragma unroll
        for (int w = 0; w < 8; ++w) tot += ssx[w * 32 + rr];
        const float rs = __builtin_amdgcn_rsqf(tot * (1.0f / 512.0f) + 1e-6f);
        __hip_bfloat16* orow = wbase + (size_t)((r & 3) + 8 * (r >> 2)) * 1024;
        orow[0] = __float2bfloat16(o[0][r] * rs); orow[32] = __float2bfloat16(o[1][r] * rs); }
    __syncthreads();
}
#undef SBAR
}
constexpr int NWAVES = 8;
constexpr int BATCH = 4, SEQ = 8192, DM = 1024, NMETA = 16, DFF = 2816, INW = 2304, LTOT = SEQ + NMETA;
constexpr int M = BATCH * SEQ;
constexpr int KVROWS = att::KVROWS;
constexpr size_t MiB = 1u << 20;
constexpr size_t WS_SS = 0;
constexpr size_t WS_SSM = 4 * (size_t)M * 4;
constexpr size_t WS_META = 1 * MiB;
constexpr size_t WS_ROPE = 2 * MiB;
constexpr size_t WS_WGU1 = 5 * MiB, WS_WD1 = 16 * MiB, WS_WIN = 22 * MiB, WS_WOUT = 27 * MiB, WS_WGU2 = 29 * MiB, WS_WD2 = 40 * MiB;
constexpr size_t WS_XB = 46 * MiB;
constexpr size_t WS_ATT = 110 * MiB;
constexpr size_t WS_HID = 174 * MiB;
constexpr size_t WS_QA = 174 * MiB, WS_QB = 206 * MiB, WS_KA = 238 * MiB, WS_VA = 271 * MiB, WS_KB = 304 * MiB, WS_VB = 313 * MiB;
constexpr size_t WS_END = 350 * MiB;
static_assert(WS_KA + (size_t)BATCH * KVROWS * 512 * 2 <= WS_VA && WS_VA + (size_t)BATCH * KVROWS * 512 * 2 <= WS_KB && WS_KB + (size_t)BATCH * KVROWS * 128 * 2 <= WS_VB && WS_VB + (size_t)BATCH * KVROWS * 128 * 2 <= WS_END, "qkv map");
static_assert(WS_HID + (size_t)M * DFF * 2 <= WS_END && (size_t)LTOT * 64 * 4 <= 3 * MiB && WS_SSM + 256 <= WS_META, "ws map");
constexpr int LDS_BYTES = 147456;
#define LAS __attribute__((address_space(3)))
typedef unsigned short bf16;
typedef unsigned v4u __attribute__((ext_vector_type(4)));
typedef float f32x4 __attribute__((ext_vector_type(4)));
typedef short bf16x8 __attribute__((ext_vector_type(8)));
__device__ __forceinline__ unsigned f2bf(float f) { unsigned u = __builtin_bit_cast(unsigned, f); return (u + 0x7fffu + ((u >> 16) & 1u)) >> 16; }
__device__ __forceinline__ unsigned pk2(float lo, float hi) { return f2bf(lo) | (f2bf(hi) << 16); }
__device__ __forceinline__ float wave_sum(float v) {
#pragma unroll
    for (int o = 1; o < 64; o <<= 1) v += __shfl_xor(v, o);
    return v;
}
template <int RM> __device__ __forceinline__ int map_row(int n) {
    if (RM == 1) return (n >> 7) * 256 + (n & 127);
    if (RM == 2) return (n >> 7) * 256 + 128 + (n & 127);
    if (RM == 3) { const int t = n >> 8, r = n & 255, hl = r >> 6, e = r & 63; return t * 256 + (e >> 5) * 128 + hl * 32 + (e & 31); }
    return n;
}
template <int RM, int GM> __device__ __forceinline__ void p0_transpose_item(const float* W, int K, int N, bf16* WT, const float* g, const float* g2, LAS float* scr, int item, int lane) {
    const int nblk = N / 32, kb = item / nblk, nb = item % nblk, k0 = 64 * kb, n0 = 32 * nb;
    float wv[32];
#pragma unroll
    for (int i = 0; i < 32; ++i) wv[i] = __builtin_nontemporal_load(W + (size_t)(k0 + 2 * i + (lane >> 5)) * N + n0 + (lane & 31));
    float gv0 = 1.f, gv1 = 1.f;
    if (GM == 1) gv0 = g[k0 + lane];
    if (GM == 2) { const int k = k0 + lane; gv0 = (k < 512) ? g[k & 127] * 0.8f : g2[k - 512]; }
    (void)gv1;
#pragma unroll
    for (int i = 0; i < 32; ++i) { const int kk = 2 * i + (lane >> 5); const float gv = (GM == 0) ? 1.f : __shfl(gv0, kk);
        scr[kk * 33 + (lane & 31)] = wv[i] * gv; }
    asm volatile("s_waitcnt lgkmcnt(0)" ::: "memory");
    const int c = lane & 7;
#pragma unroll
    for (int j = 0; j < 4; ++j) { const int n = (lane >> 3) + 8 * j; const LAS float* s = scr + (8 * c) * 33 + n;
        v4u o; o.x = pk2(s[0 * 33], s[1 * 33]); o.y = pk2(s[2 * 33], s[3 * 33]); o.z = pk2(s[4 * 33], s[5 * 33]); o.w = pk2(s[6 * 33], s[7 * 33]);
        *(v4u*)(WT + (size_t)map_row<RM>(n0 + n) * K + k0 + 8 * c) = o; }
    asm volatile("s_waitcnt lgkmcnt(0)" ::: "memory");
}
__device__ __forceinline__ void row_to_bf16_ss(const float* xrow, bf16* orow, float* ssp, int lane) {
    const f32x4* xr = (const f32x4*)xrow + lane; f32x4 v[4]; float s = 0.f;
#pragma unroll
    for (int j = 0; j < 4; ++j) { v[j] = xr[64 * j]; s += (v[j].x * v[j].x + v[j].y * v[j].y) + (v[j].z * v[j].z + v[j].w * v[j].w); }
    s = wave_sum(s);
    unsigned long long* o8 = (unsigned long long*)orow + lane;
#pragma unroll
    for (int j = 0; j < 4; ++j) o8[64 * j] = (unsigned long long)pk2(v[j].x, v[j].y) | ((unsigned long long)pk2(v[j].z, v[j].w) << 32);
    if (lane == 0) *ssp = s;
}
__device__ __forceinline__ void meta_mma2(const bf16* A, const bf16* Bt0, const bf16* Bt1, int K, f32x4& c0, f32x4& c1, int lane) {
    const int fr = lane & 15, fq = lane >> 4; c0 = (f32x4){0.f, 0.f, 0.f, 0.f}; c1 = c0;
    const bf16* ap = A + (size_t)fr * K + 8 * fq; const bf16* b0p = Bt0 + (size_t)fr * K + 8 * fq; const bf16* b1p = Bt1 + (size_t)fr * K + 8 * fq;
#pragma unroll 4
    for (int k0 = 0; k0 < K; k0 += 32) { const bf16x8 a = *(const bf16x8*)(ap + k0), b0 = *(const bf16x8*)(b0p + k0), b1 = *(const bf16x8*)(b1p + k0);
        c0 = __builtin_amdgcn_mfma_f32_16x16x32_bf16(b0, a, c0, 0, 0, 0); c1 = __builtin_amdgcn_mfma_f32_16x16x32_bf16(b1, a, c1, 0, 0, 0); }
}

#define ss0 ((float*)(args.ws + WS_SS))
#define ss1 (ss0 + M)
#define ss2 (ss0 + 2 * M)
#define ss3 (ss0 + 3 * M)
#define ssm0 ((float*)(args.ws + WS_SSM))
#define ssm1 (ssm0 + 16)
#define metab ((bf16*)(args.ws + WS_META))
#define hidm (metab + 16 * 1024)
#define h1mb (hidm + 16 * DFF)
#define rope ((float*)(args.ws + WS_ROPE))
#define WGU1 ((bf16*)(args.ws + WS_WGU1))
#define WD1 ((bf16*)(args.ws + WS_WD1))
#define WIN ((bf16*)(args.ws + WS_WIN))
#define WOUT ((bf16*)(args.ws + WS_WOUT))
#define WGU2 ((bf16*)(args.ws + WS_WGU2))
#define WD2 ((bf16*)(args.ws + WS_WD2))
#define XB ((bf16*)(args.ws + WS_XB))
#define ATT ((bf16*)(args.ws + WS_ATT))
#define HID ((bf16*)(args.ws + WS_HID))
#define QA ((bf16*)(args.ws + WS_QA))
#define QBW ((bf16*)(args.ws + WS_QB))
#define KA ((bf16*)(args.ws + WS_KA))
#define VA ((bf16*)(args.ws + WS_VA))
#define KB ((bf16*)(args.ws + WS_KB))
#define VB ((bf16*)(args.ws + WS_VB))
#define RLX_AGENT __ATOMIC_RELAXED, __HIP_MEMORY_SCOPE_AGENT
constexpr size_t WS_BAR = 1 * MiB + 512 * 1024;
constexpr int BAR_ZERO_BYTES = 16384;
constexpr int MISC_OFF = LDS_BYTES - 64;
#define XB_TMO      128
#define XB_XCNT(j)  (256  + 64 * (j))
#define XB_XSUB(j)  (1280 + 64 * (j))
#define XB_XGEN(j)  (2304 + 64 * (j))
#define XB_TOP      3328
#define XB_TOPGEN   3392
#define XCD_BAR_WORDS 3456
#define XB_SPIN_CAP (1u << 18)

__device__ __forceinline__ unsigned xb_ld(unsigned* p)              { return __hip_atomic_load(p, __ATOMIC_RELAXED, __HIP_MEMORY_SCOPE_AGENT); }
__device__ __forceinline__ unsigned xb_add(unsigned* p, unsigned v) { return __hip_atomic_fetch_add(p, v, __ATOMIC_RELAXED, __HIP_MEMORY_SCOPE_AGENT); }
__device__ __forceinline__ unsigned xb_xcc_id() { return (unsigned)__builtin_amdgcn_s_getreg((3 << 11) | 20) & 0xFu; }
#define XB_SPIN(cond, bar) do { unsigned _sp = 0; while (cond) { __builtin_amdgcn_s_sleep(1); \
    if ((++_sp & 255u) == 0u) { if (xb_ld(&(bar)[XB_TMO])) break; if (_sp > XB_SPIN_CAP) { atomicAdd(&(bar)[XB_TMO], 1u); break; } } } } while (0)

struct XcdBarrier {
    unsigned* bar; unsigned x;
    volatile LAS unsigned* st;
};

__device__ __forceinline__ XcdBarrier xcd_barrier_post(unsigned* bar, volatile LAS unsigned* st, bool leader) {
    XcdBarrier b; b.bar = bar; b.x = xb_xcc_id(); b.st = st;
    if (leader) (void)xb_add(&bar[XB_XCNT(b.x)], 1u);
    return b;
}
__device__ __forceinline__ void xcd_barrier_complete(unsigned* bar, unsigned x, unsigned& nloc, unsigned& nx) {
    const unsigned G = gridDim.x * gridDim.y * gridDim.z;
    unsigned sum, cnt, mine, sp = 0u;
    for (;;) {
        sum = 0u; cnt = 0u; mine = 0u;
#pragma unroll
        for (unsigned j = 0; j < 16; ++j) { const unsigned c = xb_ld(&bar[XB_XCNT(j)]); sum += c; cnt += (c > 0u) ? 1u : 0u; mine = (j == x) ? c : mine; }
        if (sum == G) break;
        __builtin_amdgcn_s_sleep(1);
        if ((++sp & 255u) == 0u) { if (xb_ld(&bar[XB_TMO])) break; if (sp > XB_SPIN_CAP) { atomicAdd(&bar[XB_TMO], 1u); break; } }
    }
    nloc = mine > 0u ? mine : 1u; nx = cnt > 0u ? cnt : 1u;
}

__device__ __forceinline__ void xcd_barrier(const XcdBarrier& b, bool leader) {
    asm volatile("s_waitcnt vmcnt(0)" ::: "memory");
    __syncthreads();
    if (leader) {
        unsigned* bar = b.bar;
        __builtin_amdgcn_s_waitcnt(0);
        unsigned nloc = b.st[0], nx = b.st[1];
        if (nloc == 0u) { xcd_barrier_complete(bar, b.x, nloc, nx); b.st[0] = nloc; b.st[1] = nx; }
        const unsigned old = xb_add(&bar[XB_XSUB(b.x)], 1u);
        const unsigned gen = old / nloc;
        if (old + 1u == (gen + 1u) * nloc) {
            __builtin_amdgcn_fence(__ATOMIC_RELEASE, "agent");
            asm volatile("s_waitcnt vmcnt(0)" ::: "memory");
            const unsigned og = xb_add(&bar[XB_TOP], 1u);
            const unsigned tg = og / nx;
            if (og + 1u == (tg + 1u) * nx) xb_add(&bar[XB_TOPGEN], 1u);
            else XB_SPIN(xb_ld(&bar[XB_TOPGEN]) == tg, bar);
            __builtin_amdgcn_fence(__ATOMIC_ACQUIRE, "agent");
            xb_add(&bar[XB_XGEN(b.x)], 1u);
            asm volatile("s_waitcnt vmcnt(0)" ::: "memory");
        } else {
            XB_SPIN(xb_ld(&bar[XB_XGEN(b.x)]) == gen, bar);
            __builtin_amdgcn_fence(__ATOMIC_ACQUIRE, "agent");
            asm volatile("s_waitcnt vmcnt(0)" ::: "memory");
        }
    }
    __syncthreads();
}

struct Args { const float* in[21]; float* out; unsigned char* ws; int ph_lo, ph_hi; };
constexpr int N_PHASES = 9;

__global__ void __launch_bounds__(NWAVES * 64, 2) hymba_fwd(Args args) {
    extern __shared__ __attribute__((aligned(16))) unsigned char lds[];
    __builtin_assume(__builtin_amdgcn_workitem_id_y() == 0); __builtin_assume(__builtin_amdgcn_workitem_id_z() == 0);
    LAS unsigned char* L = (LAS unsigned char*)lds;
    const int wave0 = __builtin_amdgcn_readfirstlane((int)threadIdx.x >> 6);
    const int G = gridDim.x; const int bx = blockIdx.x; const int vcu = (G % 8 == 0) ? (bx % 8) * (G / 8) + bx / 8 : bx;
    const int NGW = G * NWAVES, NGT = G * NWAVES * 64;
#define PHASE_IDS const int lane = (int)__builtin_amdgcn_mbcnt_hi(~0u, __builtin_amdgcn_mbcnt_lo(~0u, 0u)); const int wave = wave0; const int tid = wave * 64 + lane; \
    const int gw = vcu * NWAVES + wave; const int gtid = vcu * (NWAVES * 64) + tid; (void)lane; (void)gw; (void)gtid;
    const float* const x = args.in[0]; float* const out = args.out;
    const int lo = args.ph_lo, hi_ = args.ph_hi;
    XcdBarrier xbar; xbar.bar = (unsigned*)(args.ws + WS_BAR); xbar.x = 0; xbar.st = nullptr;
    const bool one_launch = (lo == 0 && hi_ == N_PHASES);
    if (one_launch) {
        const int lane0 = (int)__builtin_amdgcn_mbcnt_hi(~0u, __builtin_amdgcn_mbcnt_lo(~0u, 0u)); const bool leader0 = (wave0 == 0 && lane0 == 0);
        volatile LAS unsigned* st = (volatile LAS unsigned*)(L + MISC_OFF);
        if (leader0) { st[0] = 0u; st[1] = 0u; }
        __syncthreads();
        xbar = xcd_barrier_post((unsigned*)(args.ws + WS_BAR), st, leader0);
    }
#ifndef PHMASK
#define PHMASK 0x1ff
#endif
#define IN(k) (((PHMASK >> (k)) & 1) && lo <= (k) && (k) < hi_)
#define SEAM(k) do { if (IN(k) && IN((k) + 1)) { if (lo < 0) cg::this_grid().sync();     \
        const int lane_ = (int)__builtin_amdgcn_mbcnt_hi(~0u, __builtin_amdgcn_mbcnt_lo(~0u, 0u)); xcd_barrier(xbar, wave0 == 0 && lane_ == 0); } } while (0)

    if (IN(0)) { PHASE_IDS
        LAS float* scr = (LAS float*)(L + wave * 16384);
        constexpr int I_GU = (DM / 64) * (DFF / 32), I_DN = (DFF / 64) * (DM / 32), I_IN = (DM / 64) * (INW / 32), I_OUT = (DM / 64) * (DM / 32);
        constexpr int NITEMS = 4 * I_GU + 2 * I_DN + I_IN + I_OUT;
        for (int it = gw; it < NITEMS; it += NGW) {
            int r = it;
            if (r < I_GU) { p0_transpose_item<1, 1>(args.in[3], DM, DFF, WGU1, args.in[2], nullptr, scr, r, lane); continue; } r -= I_GU;
            if (r < I_GU) { p0_transpose_item<2, 1>(args.in[4], DM, DFF, WGU1, args.in[2], nullptr, scr, r, lane); continue; } r -= I_GU;
            if (r < I_GU) { p0_transpose_item<1, 1>(args.in[17], DM, DFF, WGU2, args.in[16], nullptr, scr, r, lane); continue; } r -= I_GU;
            if (r < I_GU) { p0_transpose_item<2, 1>(args.in[18], DM, DFF, WGU2, args.in[16], nullptr, scr, r, lane); continue; } r -= I_GU;
            if (r < I_DN) { p0_transpose_item<0, 0>(args.in[5], DFF, DM, WD1, nullptr, nullptr, scr, r, lane); continue; } r -= I_DN;
            if (r < I_DN) { p0_transpose_item<0, 0>(args.in[19], DFF, DM, WD2, nullptr, nullptr, scr, r, lane); continue; } r -= I_DN;
            if (r < I_IN) { p0_transpose_item<3, 1>(args.in[7], DM, INW, WIN, args.in[6], nullptr, scr, r, lane); continue; } r -= I_IN;
            p0_transpose_item<0, 2>(args.in[15], DM, DM, WOUT, args.in[12], args.in[14], scr, r, lane);
        }
        for (int m = gw; m < M; m += NGW) row_to_bf16_ss(x + (size_t)m * DM, XB + (size_t)m * DM, ss0 + m, lane);
        if (gw < 16) row_to_bf16_ss(args.in[1] + (size_t)gw * DM, metab + (size_t)gw * DM, ssm0 + gw, lane);
        for (int i = gtid; i < 3 * M; i += NGT) ss1[i] = 0.f;
        if (gtid < 16) ssm1[gtid] = 0.f;
        for (int i = gtid; i < LTOT * 32; i += NGT) { const int pos = i >> 5, k = i & 31;
            const float inv = exp2f(-(float)k * (13.287712379549449f / 32.0f)); const float ang = (float)pos * inv;
            rope[(size_t)pos * 64 + k] = cosf(ang); rope[(size_t)pos * 64 + 32 + k] = sinf(ang); }
    }
    SEAM(0);
    if (IN(1)) { PHASE_IDS
        if (gw < DFF / 16) { const int j = gw, t = j >> 3, within = (j & 7) * 16; const bf16* B0 = WGU1 + (size_t)(t * 256 + within) * DM; f32x4 c0, c1;
            meta_mma2(metab, B0, B0 + (size_t)128 * DM, DM, c0, c1, lane);
            const int fr = lane & 15, fq = lane >> 4; const float rs = pg8::rstd1024(ssm0[fr]);
#pragma unroll
            for (int e = 0; e < 4; ++e) hidm[(size_t)fr * DFF + j * 16 + 4 * fq + e] = (bf16)f2bf(pg8::silu_mul(c0[e] * rs, c1[e] * rs)); }
        pg8::Gemm g{XB, WGU1, M, 2 * DFF, DM}; pg8::StaticOrder S; S.init(M, 2 * DFF, G, bx);
        pg8::EpiSwiGLU E{HID, DFF, ss0};
        pg8::gemm_phase<pg8::EpiSwiGLU, pg8::StaticOrder, true, true>(L, g, S, E, tid);
    }
    SEAM(1);
    if (IN(2)) { PHASE_IDS
        if (gw < DM / 16) { const int n0 = gw * 16; f32x4 c0, c1; const bf16* B0 = WD1 + (size_t)n0 * DFF;
            meta_mma2(hidm, B0, B0, DFF, c0, c1, lane);
            const int fr = lane & 15, fq = lane >> 4; float q = 0.f;
#pragma unroll
            for (int e = 0; e < 4; ++e) { const int n = n0 + 4 * fq + e; const float v = args.in[1][(size_t)fr * DM + n] + 0.5f * c0[e]; h1mb[(size_t)fr * DM + n] = (bf16)f2bf(v); q += v * v; }
            q += __shfl_xor(q, 16); q += __shfl_xor(q, 32);
            if (fq == 0) __hip_atomic_fetch_add(ssm1 + fr, q, __ATOMIC_RELAXED, __HIP_MEMORY_SCOPE_AGENT); }
        pg8::Gemm g{HID, WD1, M, DM, DFF}; pg8::StaticOrder S; S.init(M, DM, G, bx);
        pg8::EpiResid<true> E{x, out, XB, ss1, 0.5f, DM};
        pg8::gemm_phase<pg8::EpiResid<true>, pg8::StaticOrder, true, true>(L, g, S, E, tid);
    }
    SEAM(2);
    if (IN(3)) { PHASE_IDS
        if (gw < 40) { const int ti = gw >> 3, j = gw & 7, t = (ti < 4) ? ti + 2 : 8, hl = j >> 1, i0 = (j & 1) * 16; f32x4 c0, c1;
            const bf16* B0 = WIN + (size_t)(t * 256 + hl * 32 + i0) * DM; meta_mma2(h1mb, B0, B0 + (size_t)128 * DM, DM, c0, c1, lane);
            const int fr = lane & 15, fq = lane >> 4, i = i0 + 4 * fq; const float rs = pg8::rstd1024(ssm1[fr]);
            bf16* dst; int ld, col; bool do_rope;
            if (t < 4) { dst = KA; ld = 512; col = ((t - 2) * 4 + hl) * 64; do_rope = true; }
            else if (t < 6) { dst = VA; ld = 512; col = (t - 4) * 256 + hl * 64; do_rope = false; }
            else if (hl < 2) { dst = KB; ld = 128; col = hl * 64; do_rope = true; }
            else { dst = VB; ld = 128; col = (hl - 2) * 64; do_rope = false; }
            float x1[4], x2[4];
#pragma unroll
            for (int e = 0; e < 4; ++e) { x1[e] = c0[e] * rs; x2[e] = c1[e] * rs;
                if (do_rope) { const float cs = rope[(size_t)fr * 64 + i + e], sn = rope[(size_t)fr * 64 + 32 + i + e]; const float a = x1[e] * cs - x2[e] * sn, b_ = x2[e] * cs + x1[e] * sn; x1[e] = a; x2[e] = b_; } }
            const unsigned long long w1 = (unsigned long long)pk2(x1[0], x1[1]) | ((unsigned long long)pk2(x1[2], x1[3]) << 32), w2 = (unsigned long long)pk2(x2[0], x2[1]) | ((unsigned long long)pk2(x2[2], x2[3]) << 32);
            for (int b = 0; b < BATCH; ++b) { bf16* p = dst + ((size_t)b * KVROWS + SEQ + fr) * ld + col + i; *(unsigned long long*)p = w1; *(unsigned long long*)(p + 32) = w2; } }
        { constexpr int PA = BATCH * 48 * 512 / 8, PB = BATCH * 48 * 128 / 8;
            for (int i = gtid; i < 2 * PA + 2 * PB; i += NGT) { int r = i; bf16* base; int ld;
                if (r < PA) { base = KA; ld = 512; } else if ((r -= PA) < PA) { base = VA; ld = 512; } else if ((r -= PA) < PB) { base = KB; ld = 128; } else { r -= PB; base = VB; ld = 128; }
                const int per_row = ld / 8, rowi = r / per_row, cpiece = r % per_row, b = rowi / 48, pr = rowi % 48;
                *(v4u*)(base + ((size_t)b * KVROWS + LTOT + pr) * ld + cpiece * 8) = (v4u){0u, 0u, 0u, 0u}; } }
        pg8::Gemm g{XB, WIN, M, INW, DM}; pg8::StaticOrder S; S.init(M, INW, G, bx);
        pg8::EpiQKV E{QA, KA, VA, QBW, KB, VB, ss1, rope};
        pg8::gemm_phase<pg8::EpiQKV, pg8::StaticOrder, true, true>(L, g, S, E, tid);
    }
    SEAM(3);
    if (IN(4)) { PHASE_IDS
        float lam;
        { const float a = args.in[8][lane] * args.in[9][lane], b_ = args.in[10][lane] * args.in[11][lane]; lam = expf(wave_sum(a)) - expf(wave_sum(b_)) + 0.2f; }
        const unsigned lds0 = (unsigned)(uintptr_t)lds;
        const int NDU = BATCH * 4 * (SEQ / 256), NWU = BATCH * (SEQ / 32);
        { const int per = (NDU + G - 1) / G; for (int u = vcu * per; u < (vcu + 1) * per && u < NDU; ++u) { const int bh = u >> 5, qb = u & 31; att::diff_unit(bh >> 2, bh & 3, qb, QA, KA, VA, ATT, lam, (att::lds_ptr)L, lds0, tid); } }
        { const int per = (NWU + G - 1) / G; for (int u = vcu * per; u < (vcu + 1) * per && u < NWU; ++u) { att::win_unit(u >> 8, u & 255, QBW, KB, VB, ATT, args.in[13], (att::lds_ptr)L, lds0, tid); } }
    }
    SEAM(4);
    if (IN(5)) { PHASE_IDS
        pg8::Gemm g{ATT, WOUT, M, DM, DM}; pg8::StaticOrder S; S.init(M, DM, G, bx);
        pg8::EpiResid<true> E{out, out, XB, ss2, 1.0f, DM};
        pg8::gemm_phase<pg8::EpiResid<true>, pg8::StaticOrder, true, true>(L, g, S, E, tid);
    }
    SEAM(5);
    if (IN(6)) { PHASE_IDS
        pg8::Gemm g{XB, WGU2, M, 2 * DFF, DM}; pg8::StaticOrder S; S.init(M, 2 * DFF, G, bx);
        pg8::EpiSwiGLU E{HID, DFF, ss2};
        pg8::gemm_phase<pg8::EpiSwiGLU, pg8::StaticOrder, true, true>(L, g, S, E, tid);
    }
    SEAM(6);
    if (IN(7)) { PHASE_IDS
        pg8::Gemm g{HID, WD2, M, DM, DFF}; pg8::StaticOrder S; S.init(M, DM, G, bx);
        pg8::EpiResid<false> E{out, out, nullptr, ss3, 0.5f, DM};
        pg8::gemm_phase<pg8::EpiResid<false>, pg8::StaticOrder, true, true>(L, g, S, E, tid);
    }
    SEAM(7);
    if (IN(8)) { PHASE_IDS
        const f32x4* gn = (const f32x4*)args.in[20] + lane;
        for (int m = gw; m < M; m += NGW) { const float rs = pg8::rstd1024(ss3[m]); f32x4* o = (f32x4*)(out + (size_t)m * DM) + lane;
#pragma unroll
            for (int j = 0; j < 4; ++j) o[64 * j] = o[64 * j] * rs * gn[64 * j]; }
    }
#undef IN
#undef SEAM
}

extern "C" void kernel_launch(void* const* d_in, const int* in_sizes, int n_in, void* d_out, int out_size, void* d_ws, size_t ws_size, hipStream_t stream) {
    static int grid = 0;
    if (grid == 0) {
        if (n_in != 21 || out_size != M * DM || ws_size < WS_END) { fprintf(stderr, "kernel_launch: unexpected shapes (n_in %d out %d ws %zu)\n", n_in, out_size, ws_size); grid = -1; return; }
        int dev = 0, cus = 0, per_cu = 0;
        if (hipGetDevice(&dev) != hipSuccess || hipDeviceGetAttribute(&cus, hipDeviceAttributeMultiprocessorCount, dev) != hipSuccess) { grid = -1; return; }
        if (hipFuncSetAttribute((const void*)hymba_fwd, hipFuncAttributeMaxDynamicSharedMemorySize, LDS_BYTES) != hipSuccess) { fprintf(stderr, "kernel_launch: hipFuncSetAttribute failed\n"); grid = -1; return; }
        if (hipOccupancyMaxActiveBlocksPerMultiprocessor(&per_cu, (const void*)hymba_fwd, NWAVES * 64, LDS_BYTES) != hipSuccess || per_cu < 1) { fprintf(stderr, "kernel_launch: occupancy query says %d\n", per_cu); per_cu = 1; }
        (void)hipGetLastError();
        grid = cus;
    }
    if (grid < 0) return;
    Args a{};
    for (int i = 0; i < 21; ++i) a.in[i] = (const float*)d_in[i];
    a.out = (float*)d_out; a.ws = (unsigned char*)d_ws;
#if MK_ONE_LAUNCH
    a.ph_lo = 0; a.ph_hi = N_PHASES;
    if (hipMemsetAsync((char*)d_ws + WS_BAR, 0, BAR_ZERO_BYTES, stream) != hipSuccess) { fprintf(stderr, "kernel_launch: memset of the barrier words failed\n"); return; }
    void* kargs[] = {&a};
    hipError_t e = hipLaunchCooperativeKernel((const void*)hymba_fwd, dim3(grid), dim3(NWAVES * 64), kargs, LDS_BYTES, stream);
    if (e != hipSuccess) fprintf(stderr, "kernel_launch: cooperative launch failed: %s (grid %d)\n", hipGetErrorString(e), grid);
#else
    for (int p = 0; p < N_PHASES; ++p) { a.ph_lo = p; a.ph_hi = p + 1; hipLaunchKernelGGL(hymba_fwd, dim3(grid), dim3(NWAVES * 64), LDS_BYTES, stream, a); }
#endif
}
```

```cpp
#include <hip/hip_runtime.h>
#include <hip/hip_cooperative_groups.h>
#include <hip/hip_bf16.h>
#include <cstdio>
#include <cstdint>
namespace cg = cooperative_groups;
#ifndef MK_ONE_LAUNCH
#define MK_ONE_LAUNCH 1
#endif
namespace pg8 {
#define PG8_LAS __attribute__((address_space(3)))
typedef unsigned short bf16_t;
typedef short bf16x8 __attribute__((ext_vector_type(8)));
typedef float f32x4 __attribute__((ext_vector_type(4)));
typedef unsigned u32x4 __attribute__((ext_vector_type(4)));
constexpr int BM = 256, BK = 64, HALF = 128, HTB = HALF * BK * 2  , STAGE_BYTES = 8 * HTB, NXCD = 8, WGM = 8;

__host__ __device__ __forceinline__ int lds_byte(int r, int c) { const int st = (r >> 4) * 2 + (c >> 5), rr = r & 15, cc = c & 31, ob = rr * 64 + cc * 2; return st * 1024 + (ob ^ (((ob >> 9) & 1) << 5)); }
__host__ __device__ __forceinline__ void stage_rc(int b, int& R, int& C) { const int st = b / 1024, sb = b % 1024, swz = sb ^ (((sb >> 9) & 1) << 5); R = (st >> 1) * 16 + swz / 64; C = (st & 1) * 32 + (swz % 64) / 2; }
__host__ __device__ __forceinline__ int perm32(int rho) { const int n = rho >> 4, i = rho & 15; return 8 * (i >> 2) + 4 * n + (i & 3); }

struct Unit { int pm, pn; };
struct Gemm { const bf16_t* A; const bf16_t* Bt; int M, N, K; };

struct StaticOrder {
    int nM, nN, nwg, G, c;
    __host__ __device__ void init(int M, int N, int G_, int c_) { nM = M / BM; nN = N / BM; nwg = nM * nN; G = G_; c = c_; }
    __host__ __device__ bool next(int i, Unit& u) const {
        const long L = (long)i * G + c; if (L >= nwg) return false;
        int wgid = (int)L; { const int q = nwg / NXCD, r = nwg % NXCD, xcd = wgid % NXCD, off = wgid / NXCD; wgid = (xcd < r ? xcd * (q + 1) : r * (q + 1) + (xcd - r) * q) + off; }
        const int nig = WGM * nN, gid = wgid / nig, fm = gid * WGM, gsz = (nM - fm) < WGM ? (nM - fm) : WGM;
        u.pm = fm + ((wgid % nig) % gsz); u.pn = (wgid % nig) / gsz; return true;
    }
    __device__ __forceinline__ void a_ready(const Unit&) const {}
    __device__ __forceinline__ void done(const Unit&) const {}
};

__device__ __forceinline__ unsigned cvt_pk_bf16(float lo, float hi) { unsigned r; asm volatile("v_cvt_pk_bf16_f32 %0, %1, %2" : "=v"(r) : "v"(lo), "v"(hi)); return r; }
typedef float f32x2 __attribute__((ext_vector_type(2)));
constexpr float RMS_EPS = 1e-6f;
__device__ __forceinline__ float rstd1024(float ss) { return __builtin_amdgcn_rsqf(ss * (1.0f / 1024.0f) + RMS_EPS); }
__device__ __forceinline__ float silu_mul(float g, float u) { return g * __builtin_amdgcn_rcpf(1.0f + __builtin_amdgcn_exp2f(-1.4426950408889634f * g)) * u; }

struct EpiSwiGLU {
    static constexpr bool PERM = true, AFTER_DRAIN = false;
    bf16_t* H; int ldh; const float* ss;
    __device__ __forceinline__ void operator()(const f32x4 (&acc)[2][2][4][2], const Unit& u, int wr, int wc, int fr, int fq) const {
        const int row0 = u.pm * BM + wr * 64 + fr; const int col0 = u.pn * HALF + wc * 32 + 8 * fq;
        float v8[8];
#pragma unroll
        for (int i = 0; i < 8; ++i) v8[i] = ss[row0 + (i >> 2) * HALF + (i & 3) * 16];
#pragma unroll
        for (int ai = 0; ai < 2; ++ai)
#pragma unroll
            for (int m = 0; m < 4; ++m) { const int row = row0 + ai * HALF + m * 16; const float v = v8[ai * 4 + m] * (1.0f / 1024.0f) + RMS_EPS;
                const float rs = __builtin_amdgcn_rsqf(v); const float a = rs * -1.4426950408889634f;
                float h[8];
#pragma unroll
                for (int n = 0; n < 2; ++n)
#pragma unroll
                    for (int e = 0; e < 4; ++e) { const float g = acc[ai][0][m][n][e], uu = acc[ai][1][m][n][e];
                        const float ex = __builtin_amdgcn_exp2f(g * a); const float r = __builtin_amdgcn_rcpf(__builtin_fmaf(ex, v, v)); h[n * 4 + e] = (g * uu) * r; }
                u32x4 w; w.x = cvt_pk_bf16(h[0], h[1]); w.y = cvt_pk_bf16(h[2], h[3]); w.z = cvt_pk_bf16(h[4], h[5]); w.w = cvt_pk_bf16(h[6], h[7]);
                *(u32x4*)(H + (size_t)row * ldh + col0) = w; }
    }
};
typedef unsigned u32x2 __attribute__((ext_vector_type(2)));
template <bool WB> struct EpiResid {
    static constexpr bool PERM = true, AFTER_DRAIN = false;
    const float* base; float* out; bf16_t* outb; float* ssout; float alpha; int ldc;
    __device__ __forceinline__ void operator()(const f32x4 (&acc)[2][2][4][2], const Unit& u, int wr, int wc, int fr, int fq) const {
        const int row0 = u.pm * BM + wr * 64 + fr; const int col0 = u.pn * BM + wc * 32 + 8 * fq;
#pragma unroll
        for (int ai = 0; ai < 2; ++ai)
#pragma unroll
            for (int m = 0; m < 4; ++m) { const int row = row0 + ai * HALF + m * 16; const size_t off = (size_t)row * ldc + col0; float q = 0.f;
#pragma unroll
                for (int bj = 0; bj < 2; ++bj) { const f32x4 b0 = *(const f32x4*)(base + off + bj * HALF), b1 = *(const f32x4*)(base + off + bj * HALF + 4);
                    const f32x4 o0 = b0 + acc[ai][bj][m][0] * alpha, o1 = b1 + acc[ai][bj][m][1] * alpha;
                    *(f32x4*)(out + off + bj * HALF) = o0; *(f32x4*)(out + off + bj * HALF + 4) = o1;
                    q += (o0[0] * o0[0] + o0[1] * o0[1]) + (o0[2] * o0[2] + o0[3] * o0[3]) + (o1[0] * o1[0] + o1[1] * o1[1]) + (o1[2] * o1[2] + o1[3] * o1[3]);
                    if (WB) { u32x4 w; w.x = cvt_pk_bf16(o0[0], o0[1]); w.y = cvt_pk_bf16(o0[2], o0[3]); w.z = cvt_pk_bf16(o1[0], o1[1]); w.w = cvt_pk_bf16(o1[2], o1[3]); *(u32x4*)(outb + off + bj * HALF) = w; } }
                q += __shfl_xor(q, 16); q += __shfl_xor(q, 32);
                if (fq == 0) __hip_atomic_fetch_add(ssout + row, q, __ATOMIC_RELAXED, __HIP_MEMORY_SCOPE_AGENT); }
    }
};
constexpr float QK_C2 = 0.125f * 1.4426950408889634f;
struct EpiQKV {
    static constexpr bool PERM = true, AFTER_DRAIN = false;
    bf16_t *QA, *KA, *VA, *QBW, *KB, *VB; const float* ss; const float* rope;
    __device__ __forceinline__ void operator()(const f32x4 (&acc)[2][2][4][2], const Unit& u, int wr, int wc, int fr, int fq) const {
        const int t = u.pn, hl = wc, i0 = 8 * fq; const int row0 = u.pm * BM + wr * 64 + fr;
        bf16_t* dst; int ld, col; bool do_rope, kv; float sc = 1.f;
        if (t < 2) { dst = QA; ld = 512; col = (t * 4 + hl) * 64; do_rope = true; kv = false; sc = QK_C2; }
        else if (t < 4) { dst = KA; ld = 512; col = ((t - 2) * 4 + hl) * 64; do_rope = true; kv = true; }
        else if (t < 6) { dst = VA; ld = 512; col = (t - 4) * 256 + hl * 64; do_rope = false; kv = true; }
        else if (t < 8) { dst = QBW; ld = 512; col = ((t - 6) * 4 + hl) * 64; do_rope = true; kv = false; sc = QK_C2; }
        else if (hl < 2) { dst = KB; ld = 128; col = hl * 64; do_rope = true; kv = true; }
        else { dst = VB; ld = 128; col = (hl - 2) * 64; do_rope = false; kv = true; }
        float rs8[8];
#pragma unroll
        for (int i = 0; i < 8; ++i) rs8[i] = ss[row0 + (i >> 2) * HALF + (i & 3) * 16];
#pragma unroll
        for (int ai = 0; ai < 2; ++ai)
#pragma unroll
            for (int m = 0; m < 4; ++m) { const int row = row0 + ai * HALF + m * 16; const int b = row >> 13, s = row & 8191; const float rs = rstd1024(rs8[ai * 4 + m]);
                const size_t drow = kv ? (size_t)b * 8256 + s : (size_t)row;
                f32x4 x1a = acc[ai][0][m][0] * rs, x1b = acc[ai][0][m][1] * rs, x2a = acc[ai][1][m][0] * rs, x2b = acc[ai][1][m][1] * rs;
                if (do_rope) { const float* rp = rope + (size_t)(16 + s) * 64 + i0;
                    const f32x4 ca = *(const f32x4*)(rp), cb = *(const f32x4*)(rp + 4), sa = *(const f32x4*)(rp + 32), sb = *(const f32x4*)(rp + 36);
                    const f32x4 o1a = (x1a * ca - x2a * sa) * sc, o1b = (x1b * cb - x2b * sb) * sc, o2a = (x2a * ca + x1a * sa) * sc, o2b = (x2b * cb + x1b * sb) * sc;
                    x1a = o1a; x1b = o1b; x2a = o2a; x2b = o2b; }
                u32x4 w1, w2; w1.x = cvt_pk_bf16(x1a[0], x1a[1]); w1.y = cvt_pk_bf16(x1a[2], x1a[3]); w1.z = cvt_pk_bf16(x1b[0], x1b[1]); w1.w = cvt_pk_bf16(x1b[2], x1b[3]);
                w2.x = cvt_pk_bf16(x2a[0], x2a[1]); w2.y = cvt_pk_bf16(x2a[2], x2a[3]); w2.z = cvt_pk_bf16(x2b[0], x2b[1]); w2.w = cvt_pk_bf16(x2b[2], x2b[3]);
                bf16_t* p = dst + drow * ld + col + i0; *(u32x4*)p = w1; *(u32x4*)(p + 32) = w2; }
    }
};

template <class Epi, class Sched, bool ALIGN_EPI = false, bool SP2 = false>
__device__ __forceinline__ void gemm_phase(PG8_LAS unsigned char* lds, const Gemm g, const Sched& S, const Epi& E, const int tid) {
    const int wid = __builtin_amdgcn_readfirstlane(tid >> 6), lane = tid & 63, wr = wid >> 2, wc = wid & 3, fr = lane & 15, fq = lane >> 4;
    const int K = g.K, nt = K / BK;
    unsigned voffA[2], voffB[2];
#pragma unroll
    for (int i = 0; i < 2; ++i) { int R, C; stage_rc(tid * 16 + i * 8192, R, C); const int Rb = Epi::PERM ? ((R & ~31) + perm32(R & 31)) : R;
        voffA[i] = (unsigned)(R * K + C) * 2u; voffB[i] = (unsigned)(Rb * K + C) * 2u; }
    const size_t kstep = (size_t)(BK * 2);
    const size_t hstep = (size_t)HALF * K * 2;
    const size_t tstep = 2 * hstep;
    const unsigned ldsw = (unsigned)wid * 1024u;
    const int aoff = lds_byte(wr * 64 + fr, fq * 8), boff = lds_byte(wc * 32 + fr, fq * 8);
#define PG8_SA(b, h) (((b) * 2 + (h)) * HTB)
#define PG8_SB(b, h) ((4 + (b) * 2 + (h)) * HTB)
#define PG8_STAGE(bufoff, gbase, voff) do { _Pragma("unroll") for (int _i = 0; _i < 2; ++_i) \
        __builtin_amdgcn_global_load_lds((const unsigned*)((const char*)(gbase) + (voff)[_i]), (PG8_LAS unsigned*)(lds + (bufoff) + ldsw + _i * 8192), 16, 0, 0); } while (0)
#define PG8_LDA(dst, b, h) do { _Pragma("unroll") for (int m = 0; m < 4; ++m) _Pragma("unroll") for (int k = 0; k < 2; ++k) dst[m][k] = *(const PG8_LAS bf16x8*)(lds + PG8_SA(b, h) + aoff + m * 2048 + k * 1024); } while (0)
#define PG8_LDB(dst, b, h) do { _Pragma("unroll") for (int n = 0; n < 2; ++n) _Pragma("unroll") for (int k = 0; k < 2; ++k) dst[n][k] = *(const PG8_LAS bf16x8*)(lds + PG8_SB(b, h) + boff + n * 2048 + k * 1024); } while (0)
#define PG8_MMA(ai, bj, At, Bt) do { __builtin_amdgcn_s_setprio(1); _Pragma("unroll") for (int m = 0; m < 4; ++m) _Pragma("unroll") for (int n = 0; n < 2; ++n) _Pragma("unroll") for (int k = 0; k < 2; ++k) \
        acc[ai][bj][m][n] = __builtin_amdgcn_mfma_f32_16x16x32_bf16(Bt[n][k], At[m][k], acc[ai][bj][m][n], 0, 0, 0); __builtin_amdgcn_s_setprio(0); } while (0)
#define PG8_WAIT_V(n) asm volatile("s_waitcnt vmcnt(" #n ")" ::: "memory")
#define PG8_WAIT_L(n) asm volatile("s_waitcnt lgkmcnt(" #n ")" ::: "memory")
#define PG8_BAR __builtin_amdgcn_s_barrier()
#define PG8_SCHED __builtin_amdgcn_sched_barrier(0)
    Unit cur, nxt; int ui = 0;
    if (!S.next(0, cur)) return;
    f32x4 acc[2][2][4][2];
#pragma unroll
    for (int a = 0; a < 2; ++a)
#pragma unroll
        for (int b = 0; b < 2; ++b)
#pragma unroll
            for (int m = 0; m < 4; ++m)
#pragma unroll
                for (int n = 0; n < 2; ++n) acc[a][b][m][n] = (f32x4){0.f, 0.f, 0.f, 0.f};
    bf16x8 At[4][2], B0[2][2], B1[2][2];
    const char* cA = (const char*)g.A + (size_t)cur.pm * tstep; const char* cB = (const char*)g.Bt + (size_t)cur.pn * tstep;
    S.a_ready(cur);
    if constexpr (SP2) {
        PG8_STAGE(PG8_SB(0, 0), cB, voffB); PG8_STAGE(PG8_SB(0, 1), cB + hstep, voffB); PG8_STAGE(PG8_SA(0, 0), cA, voffA); PG8_STAGE(PG8_SA(0, 1), cA + hstep, voffA);
        if (wr == 1) PG8_BAR;
        PG8_WAIT_V(2); PG8_BAR;
        PG8_STAGE(PG8_SB(1, 0), cB + kstep, voffB); PG8_STAGE(PG8_SA(1, 0), cA + kstep, voffA); PG8_STAGE(PG8_SB(1, 1), cB + hstep + kstep, voffB);
        PG8_WAIT_V(6); PG8_BAR;
    } else {
        PG8_STAGE(PG8_SB(0, 0), cB, voffB); PG8_STAGE(PG8_SA(0, 0), cA, voffA); PG8_STAGE(PG8_SB(0, 1), cB + hstep, voffB); PG8_STAGE(PG8_SA(0, 1), cA + hstep, voffA);
        if (wr == 1) PG8_BAR;
        PG8_WAIT_V(4); PG8_BAR;
        PG8_STAGE(PG8_SB(1, 0), cB + kstep, voffB); PG8_STAGE(PG8_SA(1, 0), cA + kstep, voffA); PG8_STAGE(PG8_SB(1, 1), cB + hstep + kstep, voffB);
        PG8_WAIT_V(6); PG8_BAR;
    }
    for (;;) {
        const bool has_next = S.next(ui + 1, nxt);
        const char* nA = has_next ? (const char*)g.A + (size_t)nxt.pm * tstep : cA; const char* nB = has_next ? (const char*)g.Bt + (size_t)nxt.pn * tstep : cB;
        for (int t = 0; t < nt; t += 2) {
            const bool last = (t == nt - 2);
            const char* a1 = cA + (size_t)(t + 1) * kstep;
            const char* a2 = last ? nA : cA + (size_t)(t + 2) * kstep; const char* b2 = last ? nB : cB + (size_t)(t + 2) * kstep;
            const char* a3 = a2 + kstep; const char* b3 = b2 + kstep;
            if (last && has_next) S.a_ready(nxt);
            if constexpr (SP2) {
            PG8_LDB(B0, 0, 0); PG8_LDB(B1, 0, 1); PG8_SCHED; PG8_LDA(At, 0, 0); PG8_STAGE(PG8_SA(1, 1), a1 + hstep, voffA);
            PG8_WAIT_V(8); PG8_WAIT_L(0); PG8_BAR; PG8_MMA(0, 0, At, B0); PG8_MMA(0, 1, At, B1); PG8_BAR; PG8_SCHED;
            PG8_LDA(At, 0, 1); PG8_STAGE(PG8_SB(0, 0), b2, voffB); PG8_STAGE(PG8_SB(0, 1), b2 + hstep, voffB); PG8_STAGE(PG8_SA(0, 0), a2, voffA);
            PG8_WAIT_V(8); PG8_WAIT_L(0); PG8_BAR; PG8_MMA(1, 0, At, B0); PG8_MMA(1, 1, At, B1); PG8_BAR; PG8_SCHED;
            PG8_LDB(B0, 1, 0); PG8_LDB(B1, 1, 1); PG8_SCHED; PG8_LDA(At, 1, 0); PG8_STAGE(PG8_SA(0, 1), a2 + hstep, voffA);
            PG8_WAIT_V(8); PG8_WAIT_L(0); PG8_BAR; PG8_MMA(0, 0, At, B0); PG8_MMA(0, 1, At, B1); PG8_BAR; PG8_SCHED;
            PG8_LDA(At, 1, 1); PG8_STAGE(PG8_SB(1, 0), b3, voffB); PG8_STAGE(PG8_SB(1, 1), b3 + hstep, voffB); PG8_STAGE(PG8_SA(1, 0), a3, voffA);
            PG8_WAIT_V(8); PG8_WAIT_L(0); PG8_BAR; PG8_MMA(1, 0, At, B0); PG8_MMA(1, 1, At, B1); PG8_BAR; PG8_SCHED;
            } else {
            PG8_LDB(B0, 0, 0); PG8_SCHED; PG8_LDA(At, 0, 0); PG8_STAGE(PG8_SA(1, 1), a1 + hstep, voffA);
            PG8_WAIT_L(8); PG8_BAR; PG8_WAIT_L(0); PG8_MMA(0, 0, At, B0); PG8_BAR; PG8_SCHED;
            PG8_LDB(B1, 0, 1); PG8_STAGE(PG8_SB(0, 0), b2, voffB);
            PG8_BAR; PG8_WAIT_L(0); PG8_MMA(0, 1, At, B1); PG8_BAR;
            PG8_LDA(At, 0, 1); PG8_STAGE(PG8_SA(0, 0), a2, voffA);
            PG8_BAR; PG8_WAIT_L(0); PG8_MMA(1, 0, At, B0); PG8_BAR; PG8_SCHED;
            PG8_STAGE(PG8_SB(0, 1), b2 + hstep, voffB);
            PG8_WAIT_V(6); PG8_BAR; PG8_MMA(1, 1, At, B1); PG8_BAR;
            PG8_LDB(B0, 1, 0); PG8_SCHED; PG8_LDA(At, 1, 0); PG8_STAGE(PG8_SA(0, 1), a2 + hstep, voffA);
            PG8_WAIT_L(8); PG8_BAR; PG8_WAIT_L(0); PG8_MMA(0, 0, At, B0); PG8_BAR; PG8_SCHED;
            PG8_LDB(B1, 1, 1); PG8_STAGE(PG8_SB(1, 0), b3, voffB);
            PG8_BAR; PG8_WAIT_L(0); PG8_MMA(0, 1, At, B1); PG8_BAR;
            PG8_LDA(At, 1, 1); PG8_STAGE(PG8_SA(1, 0), a3, voffA);
            PG8_BAR; PG8_WAIT_L(0); PG8_MMA(1, 0, At, B0); PG8_BAR; PG8_SCHED;
            PG8_STAGE(PG8_SB(1, 1), b3 + hstep, voffB);
            PG8_WAIT_V(6); PG8_BAR; PG8_MMA(1, 1, At, B1); PG8_BAR;
            }
        }
        if constexpr (ALIGN_EPI) { if (wr == 0) PG8_BAR; }
        if constexpr (!Epi::AFTER_DRAIN) { E(acc, cur, wr, wc, fr, fq); S.done(cur); }
        if (!has_next) break;
#pragma unroll
        for (int a = 0; a < 2; ++a)
#pragma unroll
            for (int b = 0; b < 2; ++b)
#pragma unroll
                for (int m = 0; m < 4; ++m)
#pragma unroll
                    for (int n = 0; n < 2; ++n) acc[a][b][m][n] = (f32x4){0.f, 0.f, 0.f, 0.f};
        cur = nxt; cA = nA; cB = nB; ++ui;
        if constexpr (ALIGN_EPI) { if (wr == 1) PG8_BAR; }
    }
    PG8_WAIT_V(0);
    if constexpr (!ALIGN_EPI) { if (wr == 0) PG8_BAR; }
    PG8_BAR;
    if constexpr (Epi::AFTER_DRAIN) { E.fused(acc, cur, wr, wc, fr, fq, lds, wid, lane); S.done(cur); }
#undef PG8_SA
#undef PG8_SB
#undef PG8_STAGE
#undef PG8_LDA
#undef PG8_LDB
#undef PG8_MMA
#undef PG8_WAIT_V
#undef PG8_WAIT_L
#undef PG8_BAR
#undef PG8_SCHED
}
}
namespace att {
#define ATT_LAS __attribute__((address_space(3)))
typedef unsigned short bf16_t;
typedef short bf16x8 __attribute__((ext_vector_type(8)));
typedef short s16x4 __attribute__((ext_vector_type(4)));
typedef float f32x16 __attribute__((ext_vector_type(16)));
typedef unsigned u32x4 __attribute__((ext_vector_type(4)));
typedef float f32x2_t __attribute__((ext_vector_type(2))); typedef __bf16 bf16x2_t __attribute__((ext_vector_type(2)));
#define SBAR() __builtin_amdgcn_sched_barrier(0)
__device__ __forceinline__ int crow(int r, int hi) { return (r & 3) + 8 * (r >> 2) + 4 * hi; }
__device__ __forceinline__ unsigned cvtpk_s(float lo, float hi) { f32x2_t v = {lo, hi}; bf16x2_t b = __builtin_convertvector(v, bf16x2_t); return __builtin_bit_cast(unsigned, b); }
__device__ __forceinline__ float bf_lo(unsigned w) { return __uint_as_float(w << 16); }
__device__ __forceinline__ float bf_hi(unsigned w) { return __uint_as_float(w & 0xffff0000u); }
typedef ATT_LAS const char* lds_cptr;
typedef ATT_LAS char* lds_ptr;
__device__ __forceinline__ void qkt(f32x16& p0, f32x16& p1, lds_cptr Kslot, const bf16x8* qr, int r32, int hi) {
    const f32x16 negm = {0.f,0.f,0.f,0.f,0.f,0.f,0.f,0.f,0.f,0.f,0.f,0.f,0.f,0.f,0.f,0.f};
    lds_cptr kb = Kslot + hi * 1024 + r32 * 16;
#pragma unroll
    for (int d0 = 0; d0 < 4; ++d0) {
        const bf16x8 b0 = *(const ATT_LAS bf16x8*)(kb + d0 * 2048);
        const bf16x8 b1 = *(const ATT_LAS bf16x8*)(kb + d0 * 2048 + 512);
        if (d0 == 0) { p0 = __builtin_amdgcn_mfma_f32_32x32x16_bf16(b0, qr[0], negm, 0, 0, 0); p1 = __builtin_amdgcn_mfma_f32_32x32x16_bf16(b1, qr[0], negm, 0, 0, 0); }
        else { p0 = __builtin_amdgcn_mfma_f32_32x32x16_bf16(b0, qr[d0], p0, 0, 0, 0); p1 = __builtin_amdgcn_mfma_f32_32x32x16_bf16(b1, qr[d0], p1, 0, 0, 0); } }
}
__device__ __forceinline__ float rowmax(const f32x16& p0, const f32x16& p1) {
    float a = __builtin_fmaxf(p0[0], p1[0]), b = __builtin_fmaxf(p0[1], p1[1]);
#pragma unroll
    for (int r = 2; r < 16; r += 2) { a = __builtin_fmaxf(a, __builtin_fmaxf(p0[r], p1[r])); b = __builtin_fmaxf(b, __builtin_fmaxf(p0[r + 1], p1[r + 1])); }
    const float m = __builtin_fmaxf(a, b);
    return __builtin_fmaxf(m, __shfl_xor(m, 32));
}
__device__ __forceinline__ float max3f(float a, float b, float c) { float r; asm("v_max3_f32 %0, %1, %2, %3" : "=v"(r) : "v"(a), "v"(b), "v"(c)); return r; }
__device__ __forceinline__ float max2f(float a, float b) { float r; asm("v_max_f32_e32 %0, %1, %2" : "=v"(r) : "v"(a), "v"(b)); return r; }
__device__ __forceinline__ float rowmax_fast(const f32x16& p0, const f32x16& p1) {
    float a = max3f(p0[0], p0[1], p1[0]), b = max3f(p0[2], p0[3], p1[1]); a = max3f(a, p1[2], p1[3]);
#pragma unroll
    for (int r = 4; r < 16; r += 4) { a = max3f(a, p0[r], p0[r + 1]); b = max3f(b, p0[r + 2], p0[r + 3]); a = max3f(a, p1[r], p1[r + 1]); b = max3f(b, p1[r + 2], p1[r + 3]); }
    const float m = max2f(a, b);
    auto rr = __builtin_amdgcn_permlane32_swap(__float_as_uint(m), __float_as_uint(m), false, false);
    return max2f(__uint_as_float(rr[0]), __uint_as_float(rr[1]));
}
template <int NDQ> __device__ __forceinline__ void pv(f32x16* o, int vb, bf16x8 pa0, bf16x8 pa1, bf16x8 pa2, bf16x8 pa3) {
#pragma unroll
    for (int d0 = 0; d0 < NDQ; ++d0) { s16x4 lo[4], hi[4];
#pragma unroll
        for (int ks = 0; ks < 4; ++ks) {
            asm volatile("ds_read_b64_tr_b16 %0,%1 offset:%c2" : "=&v"(lo[ks]) : "v"(vb), "i"(d0 * 4096 + ks * 1024) : "memory");
            asm volatile("ds_read_b64_tr_b16 %0,%1 offset:%c2" : "=&v"(hi[ks]) : "v"(vb), "i"(d0 * 4096 + ks * 1024 + 512) : "memory"); }
        asm volatile("s_waitcnt lgkmcnt(0)" ::: "memory"); SBAR();
#define ATT_PK(k) (bf16x8){lo[k][0], lo[k][1], lo[k][2], lo[k][3], hi[k][0], hi[k][1], hi[k][2], hi[k][3]}
        o[d0] = __builtin_amdgcn_mfma_f32_32x32x16_bf16(pa0, ATT_PK(0), o[d0], 0, 0, 0);
        o[d0] = __builtin_amdgcn_mfma_f32_32x32x16_bf16(pa1, ATT_PK(1), o[d0], 0, 0, 0);
        o[d0] = __builtin_amdgcn_mfma_f32_32x32x16_bf16(pa2, ATT_PK(2), o[d0], 0, 0, 0);
        o[d0] = __builtin_amdgcn_mfma_f32_32x32x16_bf16(pa3, ATT_PK(3), o[d0], 0, 0, 0);
#undef ATT_PK
    }
}
template <int NDQ> __device__ __forceinline__ void softmax_pv(f32x16& p0, f32x16& p1, float& mref, float& l, f32x16* o, int vb, int r32, ATT_LAS float* wsf, const ATT_LAS float* wsh) {
    const float rm = rowmax_fast(p0, p1) - mref;
    if (__any(rm > 8.0f)) {
        const float dl = __builtin_fmaxf(rm, 0.f); mref += dl;
        const float f = __builtin_amdgcn_exp2f(-dl); l *= f;
        wsf[r32] = f;
#pragma unroll
        for (int r = 0; r < 16; ++r) { const float fr_ = wsh[(r & 3) + 8 * (r >> 2)];
#pragma unroll
            for (int d = 0; d < NDQ; ++d) o[d][r] *= fr_; }
    }
    float s0 = 0.f, s1 = 0.f;
#pragma unroll
    for (int r = 0; r < 16; ++r) { p0[r] = __builtin_amdgcn_exp2f(p0[r] - mref); p1[r] = __builtin_amdgcn_exp2f(p1[r] - mref); s0 += p0[r]; s1 += p1[r]; }
    l += s0 + s1;
    u32x4 pw0, pw1, pw2, pw3;
    pw0 = (u32x4){cvtpk_s(p0[0], p0[1]), cvtpk_s(p0[2], p0[3]), cvtpk_s(p0[4], p0[5]), cvtpk_s(p0[6], p0[7])};
    pw1 = (u32x4){cvtpk_s(p0[8], p0[9]), cvtpk_s(p0[10], p0[11]), cvtpk_s(p0[12], p0[13]), cvtpk_s(p0[14], p0[15])};
    pw2 = (u32x4){cvtpk_s(p1[0], p1[1]), cvtpk_s(p1[2], p1[3]), cvtpk_s(p1[4], p1[5]), cvtpk_s(p1[6], p1[7])};
    pw3 = (u32x4){cvtpk_s(p1[8], p1[9]), cvtpk_s(p1[10], p1[11]), cvtpk_s(p1[12], p1[13]), cvtpk_s(p1[14], p1[15])};
    SBAR();
    pv<NDQ>(o, vb, __builtin_bit_cast(bf16x8, pw0), __builtin_bit_cast(bf16x8, pw1), __builtin_bit_cast(bf16x8, pw2), __builtin_bit_cast(bf16x8, pw3));
}
__device__ __forceinline__ f32x16 splat16(float v) { f32x16 x;
#pragma unroll
    for (int r = 0; r < 16; ++r) x[r] = v; return x; }
constexpr int KVROWS = 8256, NREAL = 8192, NKT = 129;
constexpr float NEG_INF = -__builtin_inff();

#ifndef ATT_NEGM
#define ATT_NEGM 0
#endif
#ifndef ATT_PVF
#define ATT_PVF pv2
#endif
template <int NDQ> __device__ __forceinline__ void pv2(f32x16* o, int vb, bf16x8 pa0, bf16x8 pa1, bf16x8 pa2, bf16x8 pa3) {
    s16x4 lo[2][4], hi[2][4];
#define ATT_RD(S, D) do { _Pragma("unroll") for (int ks = 0; ks < 4; ++ks) { \
        asm volatile("ds_read_b64_tr_b16 %0,%1 offset:%c2" : "=&v"(lo[S][ks]) : "v"(vb), "i"((D) * 4096 + ks * 1024) : "memory"); \
        asm volatile("ds_read_b64_tr_b16 %0,%1 offset:%c2" : "=&v"(hi[S][ks]) : "v"(vb), "i"((D) * 4096 + ks * 1024 + 512) : "memory"); } } while (0)
#define ATT_PK2(S, k) (bf16x8){lo[S][k][0], lo[S][k][1], lo[S][k][2], lo[S][k][3], hi[S][k][0], hi[S][k][1], hi[S][k][2], hi[S][k][3]}
    ATT_RD(0, 0);
#pragma unroll
    for (int d0 = 0; d0 < NDQ; ++d0) {
        if (d0 + 1 < NDQ) { if ((d0 & 1) == 0) ATT_RD(1, d0 + 1); else ATT_RD(0, d0 + 1); asm volatile("s_waitcnt lgkmcnt(8)" ::: "memory"); }
        else asm volatile("s_waitcnt lgkmcnt(0)" ::: "memory");
        SBAR();
        if ((d0 & 1) == 0) {
            o[d0] = __builtin_amdgcn_mfma_f32_32x32x16_bf16(pa0, ATT_PK2(0, 0), o[d0], 0, 0, 0); o[d0] = __builtin_amdgcn_mfma_f32_32x32x16_bf16(pa1, ATT_PK2(0, 1), o[d0], 0, 0, 0);
            o[d0] = __builtin_amdgcn_mfma_f32_32x32x16_bf16(pa2, ATT_PK2(0, 2), o[d0], 0, 0, 0); o[d0] = __builtin_amdgcn_mfma_f32_32x32x16_bf16(pa3, ATT_PK2(0, 3), o[d0], 0, 0, 0);
        } else {
            o[d0] = __builtin_amdgcn_mfma_f32_32x32x16_bf16(pa0, ATT_PK2(1, 0), o[d0], 0, 0, 0); o[d0] = __builtin_amdgcn_mfma_f32_32x32x16_bf16(pa1, ATT_PK2(1, 1), o[d0], 0, 0, 0);
            o[d0] = __builtin_amdgcn_mfma_f32_32x32x16_bf16(pa2, ATT_PK2(1, 2), o[d0], 0, 0, 0); o[d0] = __builtin_amdgcn_mfma_f32_32x32x16_bf16(pa3, ATT_PK2(1, 3), o[d0], 0, 0, 0);
        }
        SBAR();
    }
#undef ATT_RD
#undef ATT_PK2
}
struct VFrag { s16x4 lo[2][4], hi[2][4]; };
#define ATT_RDF(F, S, D) do { _Pragma("unroll") for (int ks = 0; ks < 4; ++ks) { \
        asm volatile("ds_read_b64_tr_b16 %0,%1 offset:%c2" : "=&v"(F.lo[S][ks]) : "v"(vb), "i"((D) * 4096 + ks * 1024) : "memory"); \
        asm volatile("ds_read_b64_tr_b16 %0,%1 offset:%c2" : "=&v"(F.hi[S][ks]) : "v"(vb), "i"((D) * 4096 + ks * 1024 + 512) : "memory"); } } while (0)
#define ATT_PKF(F, S, k) (bf16x8){F.lo[S][k][0], F.lo[S][k][1], F.lo[S][k][2], F.lo[S][k][3], F.hi[S][k][0], F.hi[S][k][1], F.hi[S][k][2], F.hi[S][k][3]}
__device__ __forceinline__ void pv4_issue0(VFrag& F, int vb) { ATT_RDF(F, 0, 0); }
__device__ __forceinline__ void pv4_rest(VFrag& F, f32x16* o, int vb, bf16x8 pa0, bf16x8 pa1, bf16x8 pa2, bf16x8 pa3) {
#pragma unroll
    for (int d0 = 0; d0 < 4; ++d0) {
        if (d0 + 1 < 4) { if ((d0 & 1) == 0) ATT_RDF(F, 1, d0 + 1); else ATT_RDF(F, 0, d0 + 1); asm volatile("s_waitcnt lgkmcnt(8)" ::: "memory"); }
        else asm volatile("s_waitcnt lgkmcnt(0)" ::: "memory");
        SBAR();
        if ((d0 & 1) == 0) {
            o[d0] = __builtin_amdgcn_mfma_f32_32x32x16_bf16(pa0, ATT_PKF(F, 0, 0), o[d0], 0, 0, 0); o[d0] = __builtin_amdgcn_mfma_f32_32x32x16_bf16(pa1, ATT_PKF(F, 0, 1), o[d0], 0, 0, 0);
            o[d0] = __builtin_amdgcn_mfma_f32_32x32x16_bf16(pa2, ATT_PKF(F, 0, 2), o[d0], 0, 0, 0); o[d0] = __builtin_amdgcn_mfma_f32_32x32x16_bf16(pa3, ATT_PKF(F, 0, 3), o[d0], 0, 0, 0);
        } else {
            o[d0] = __builtin_amdgcn_mfma_f32_32x32x16_bf16(pa0, ATT_PKF(F, 1, 0), o[d0], 0, 0, 0); o[d0] = __builtin_amdgcn_mfma_f32_32x32x16_bf16(pa1, ATT_PKF(F, 1, 1), o[d0], 0, 0, 0);
            o[d0] = __builtin_amdgcn_mfma_f32_32x32x16_bf16(pa2, ATT_PKF(F, 1, 2), o[d0], 0, 0, 0); o[d0] = __builtin_amdgcn_mfma_f32_32x32x16_bf16(pa3, ATT_PKF(F, 1, 3), o[d0], 0, 0, 0);
        }
        SBAR();
    }
}
__device__ __forceinline__ void qkt_c(f32x16& p0, f32x16& p1, lds_cptr Kslot, const bf16x8* qr, const f32x16& negm, int r32, int hi) {
    lds_cptr kb = Kslot + hi * 1024 + r32 * 16;
#pragma unroll
    for (int d0 = 0; d0 < 4; ++d0) {
        const bf16x8 b0 = *(const ATT_LAS bf16x8*)(kb + d0 * 2048);
        const bf16x8 b1 = *(const ATT_LAS bf16x8*)(kb + d0 * 2048 + 512);
        if (d0 == 0) { p0 = __builtin_amdgcn_mfma_f32_32x32x16_bf16(b0, qr[0], negm, 0, 0, 0); p1 = __builtin_amdgcn_mfma_f32_32x32x16_bf16(b1, qr[0], negm, 0, 0, 0); }
        else { p0 = __builtin_amdgcn_mfma_f32_32x32x16_bf16(b0, qr[d0], p0, 0, 0, 0); p1 = __builtin_amdgcn_mfma_f32_32x32x16_bf16(b1, qr[d0], p1, 0, 0, 0); } }
}
__device__ __forceinline__ void kload8(bf16x8* kf, lds_cptr kp) {
#pragma unroll
    for (int d0 = 0; d0 < 4; ++d0) { kf[2 * d0] = *(const ATT_LAS bf16x8*)(kp + d0 * 2048); kf[2 * d0 + 1] = *(const ATT_LAS bf16x8*)(kp + d0 * 2048 + 512); }
}
__device__ __forceinline__ void qk_held(f32x16& p0, f32x16& p1, const bf16x8* kf, const bf16x8* qr) {
    const f32x16 z = {0.f,0.f,0.f,0.f,0.f,0.f,0.f,0.f,0.f,0.f,0.f,0.f,0.f,0.f,0.f,0.f};
    p0 = __builtin_amdgcn_mfma_f32_32x32x16_bf16(kf[0], qr[0], z, 0, 0, 0); p1 = __builtin_amdgcn_mfma_f32_32x32x16_bf16(kf[1], qr[0], z, 0, 0, 0);
#pragma unroll
    for (int d0 = 1; d0 < 4; ++d0) { p0 = __builtin_amdgcn_mfma_f32_32x32x16_bf16(kf[2 * d0], qr[d0], p0, 0, 0, 0); p1 = __builtin_amdgcn_mfma_f32_32x32x16_bf16(kf[2 * d0 + 1], qr[d0], p1, 0, 0, 0); }
}
__device__ __forceinline__ void glds16(const void* gsrc, unsigned lds_dst) { unsigned keep;
    asm volatile("s_mov_b32 %0, m0\n\ts_mov_b32 m0, %2\n\ts_nop 0\n\tglobal_load_lds_dwordx4 %1, off\n\ts_mov_b32 m0, %0" : "=&s"(keep) : "v"(gsrc), "s"(lds_dst) : "memory"); }
__device__ __forceinline__ void diff_unit(int b, int h, int qb, const bf16_t* QA, const bf16_t* KA, const bf16_t* VA, bf16_t* ATT, float lam, lds_ptr lds, unsigned lds0, const int tid) {
    const int lane = tid & 63, r32 = lane & 31, hi = lane >> 5; const int wid = __builtin_amdgcn_readfirstlane(tid >> 6);
    const int grp = wid >> 2;
    const size_t m0 = (size_t)b * NREAL + (size_t)qb * 256 + wid * 32; const size_t kv0 = (size_t)b * KVROWS;
    const int vlane = ((lane >> 4) & 1) * 32 + (lane & 3) * 8 + (4 * hi + ((lane & 15) >> 2)) * 64;
    ATT_LAS float* wsf = (ATT_LAS float*)(lds + 131072 + wid * 256); const ATT_LAS float* wsh = wsf + 4 * hi;
#pragma unroll 1
    for (int c = 0; c < 2; ++c) {
        const int ch = h * 2 + c;
        bf16x8 qr[4];
#pragma unroll
        for (int d0 = 0; d0 < 4; ++d0) qr[d0] = *(const bf16x8*)(QA + m0 * 512 + ch * 64 + ((unsigned)r32 * 512u + (unsigned)hi * 8u + d0 * 16));
        const bf16_t* ksrc_u = KA + kv0 * 512 + ch * 64 + wid * 8; const unsigned koff = (unsigned)lane * 512u;
        const bf16_t* vsrc_u = VA + (kv0 + (wid & 3) * 16) * 512 + h * 128 + (wid >> 2) * 32; const unsigned voff = (unsigned)(lane >> 2) * 512u + (unsigned)(lane & 3) * 8u;
#define DMA_K(T) glds16(ksrc_u + koff + (size_t)(T) * 64 * 512, (unsigned)__builtin_amdgcn_readfirstlane(lds0 + (unsigned)(((T) & 3) * 8192 + wid * 1024)))
#define DMA_V(T) do { const bf16_t* vp_ = vsrc_u + voff + (size_t)(T) * 64 * 512; const unsigned vd_ = lds0 + (unsigned)(32768 + ((T) & 3) * 16384 + wid * 1024); \
            glds16(vp_, (unsigned)__builtin_amdgcn_readfirstlane(vd_)); glds16(vp_ + 64, (unsigned)__builtin_amdgcn_readfirstlane(vd_ + 8192u)); } while (0)
        DMA_K(0); DMA_V(0); DMA_K(1); DMA_V(1); DMA_K(2); DMA_V(2); DMA_K(3);
        asm volatile("s_waitcnt vmcnt(0) lgkmcnt(0)\n\ts_barrier" ::: "memory");
        f32x16 o[4];
#pragma unroll
        for (int d = 0; d < 4; ++d) o[d] = splat16(0.f);
        float mref = 0.f, l = 0.f; f32x16 negm = splat16(0.f); asm volatile("" : "+v"(negm));
        f32x16 p0, p1; u32x4 pw0 = {0u, 0u, 0u, 0u}, pw1 = pw0, pw2 = pw0, pw3 = pw0;
        qkt(p0, p1, (lds_cptr)lds, qr, r32, hi); asm volatile("s_nop 15\n\ts_nop 15" : "+v"(p0), "+v"(p1));
        { const float rm0 = rowmax_fast(p0, p1); mref = rm0;
#pragma unroll
          for (int r = 0; r < 16; ++r) { p0[r] -= rm0; p1[r] -= rm0; }
          negm = splat16(-mref); asm volatile("" : "+v"(negm)); }
#define DIFF_X(T, MASK) do { \
            if (MASK) { _Pragma("unroll") for (int r = 0; r < 16; ++r) { if (r >= 8) p0[r] = NEG_INF; p1[r] = NEG_INF; } } \
            const float rm = rowmax_fast(p0, p1); \
            if (__any(rm > 8.0f)) { const float dl = __builtin_fmaxf(rm, 0.f); mref += dl; \
                _Pragma("unroll") for (int r = 0; r < 16; ++r) { p0[r] -= dl; p1[r] -= dl; } \
                negm = splat16(-mref); asm volatile("" : "+v"(negm)); \
                const float f = __builtin_amdgcn_exp2f(-dl); l *= f; wsf[r32] = f; \
                _Pragma("unroll") for (int r = 0; r < 16; ++r) { const float fr_ = wsh[(r & 3) + 8 * (r >> 2)]; _Pragma("unroll") for (int d = 0; d < 4; ++d) o[d][r] *= fr_; } } \
            float s0 = 0.f, s1 = 0.f; \
            _Pragma("unroll") for (int r = 0; r < 16; ++r) { p0[r] = __builtin_amdgcn_exp2f(p0[r]); p1[r] = __builtin_amdgcn_exp2f(p1[r]); s0 += p0[r]; s1 += p1[r]; } \
            l += s0 + s1; \
            pw0 = (u32x4){cvtpk_s(p0[0], p0[1]), cvtpk_s(p0[2], p0[3]), cvtpk_s(p0[4], p0[5]), cvtpk_s(p0[6], p0[7])}; \
            pw1 = (u32x4){cvtpk_s(p0[8], p0[9]), cvtpk_s(p0[10], p0[11]), cvtpk_s(p0[12], p0[13]), cvtpk_s(p0[14], p0[15])}; \
            pw2 = (u32x4){cvtpk_s(p1[0], p1[1]), cvtpk_s(p1[2], p1[3]), cvtpk_s(p1[4], p1[5]), cvtpk_s(p1[6], p1[7])}; \
            pw3 = (u32x4){cvtpk_s(p1[8], p1[9]), cvtpk_s(p1[10], p1[11]), cvtpk_s(p1[12], p1[13]), cvtpk_s(p1[14], p1[15])}; } while (0)
#define DIFF_Y(T) do { VFrag vf_; const int vb_ = (int)(lds0 + 32768 + ((T) & 3) * 16384) + vlane; \
            pv4_issue0(vf_, vb_); \
            const bf16x8 pa0_ = __builtin_bit_cast(bf16x8, pw0), pa1_ = __builtin_bit_cast(bf16x8, pw1), pa2_ = __builtin_bit_cast(bf16x8, pw2), pa3_ = __builtin_bit_cast(bf16x8, pw3); \
            if ((T) + 1 < NKT) { qkt_c(p0, p1, (lds_cptr)(lds + (((T) + 1) & 3) * 8192), qr, negm, r32, hi); } \
            SBAR(); \
            pv4_rest(vf_, o, vb_, pa0_, pa1_, pa2_, pa3_); \
            asm volatile("s_nop 7" : "+v"(p0), "+v"(p1)); } while (0)
#define DIFF_STAGE(T) do { if ((T) + 4 < NKT) DMA_K((T) + 4); if ((T) + 3 < NKT) DMA_V((T) + 3); } while (0)
#define DIFF_BARV(T) do { if ((T) + 6 < NKT) asm volatile("s_waitcnt vmcnt(6) lgkmcnt(0)\n\ts_barrier" ::: "memory"); else asm volatile("s_waitcnt vmcnt(0) lgkmcnt(0)\n\ts_barrier" ::: "memory"); } while (0)
#define DIFF_PINX() asm volatile("" : "+v"(pw0), "+v"(pw1), "+v"(pw2), "+v"(pw3), "+v"(l))
#pragma unroll 1
        for (int t = 0; t < NKT - 1; ++t) {
            if (grp == 1) { DIFF_BARV(t); DIFF_STAGE(t); }
            DIFF_X(t, false);
            DIFF_PINX();
            if (grp == 0) { DIFF_BARV(t); DIFF_STAGE(t); }
            DIFF_Y(t);
        }
        {
            if (grp == 1) DIFF_BARV(NKT - 1);
            DIFF_X(NKT - 1, true);
            DIFF_PINX();
            if (grp == 0) DIFF_BARV(NKT - 1);
            DIFF_Y(NKT - 1);
        }
        asm volatile("s_waitcnt vmcnt(0) lgkmcnt(0)\n\ts_barrier" ::: "memory");
#undef DIFF_BARV
#undef DIFF_PINX
#undef DIFF_STAGE
#undef DIFF_X
#undef DIFF_Y
#undef DMA_K
#undef DMA_V
        const float lt = l + __shfl_xor(l, 32); const float il = 1.0f / lt;
        wsf[r32] = il;
        __hip_bfloat16* obase = (__hip_bfloat16*)ATT + (m0 + 4 * hi) * 1024 + h * 128 + r32; asm volatile("" : "+v"(obase));
        if (c == 0) {
#pragma unroll
            for (int r = 0; r < 16; ++r) { const float rl = wsh[(r & 3) + 8 * (r >> 2)]; __hip_bfloat16* orow = obase + (size_t)((r & 3) + 8 * (r >> 2)) * 1024;
#pragma unroll
                for (int d = 0; d < 4; ++d) orow[d * 32] = __float2bfloat16(o[d][r] * rl); }
        } else {
#pragma unroll
            for (int r = 0; r < 16; ++r) { const float rl = wsh[(r & 3) + 8 * (r >> 2)]; float q = 0.f; __hip_bfloat16* orow = obase + (size_t)((r & 3) + 8 * (r >> 2)) * 1024;
#pragma unroll
                for (int d = 0; d < 4; ++d) { const float a0 = __bfloat162float(orow[d * 32]); const float v = a0 - lam * (o[d][r] * rl); o[d][r] = v; q += v * v; }
                q += __shfl_xor(q, 1); q += __shfl_xor(q, 2); q += __shfl_xor(q, 4); q += __shfl_xor(q, 8); q += __shfl_xor(q, 16);
                const float rs = __builtin_amdgcn_rsqf(q * (1.0f / 128.0f) + 1e-6f);
#pragma unroll
                for (int d = 0; d < 4; ++d) orow[d * 32] = __float2bfloat16(o[d][r] * rs); }
        }
    }
}

__device__ __forceinline__ void win_unit(int b, int qb, const bf16_t* QBW, const bf16_t* KB, const bf16_t* VB, bf16_t* ATT, const float* sink, lds_ptr lds, unsigned lds0, const int tid) {
    const int lane = tid & 63, r32 = lane & 31, hi = lane >> 5; const int wid = __builtin_amdgcn_readfirstlane(tid >> 6);
    const int hq = wid, hk = wid >> 2; const int q0 = qb * 32; const size_t m0 = (size_t)b * NREAL + q0; const size_t kv0 = (size_t)b * KVROWS;
    const int vlane = ((lane >> 4) & 1) * 32 + (lane & 3) * 8 + (4 * hi + ((lane & 15) >> 2)) * 64;
    ATT_LAS float* wsf = (ATT_LAS float*)(lds + 131072 + wid * 256); const ATT_LAS float* wsh = wsf + 4 * hi;
    bf16x8 qr[4];
#pragma unroll
    for (int d0 = 0; d0 < 4; ++d0) qr[d0] = *(const bf16x8*)(QBW + m0 * 512 + hq * 64 + ((unsigned)r32 * 512u + (unsigned)hi * 8u + d0 * 16));
    f32x16 o[2]; o[0] = splat16(0.f); o[1] = splat16(0.f);
    float mref = 0.f, l = (hi == 0) ? __builtin_amdgcn_exp2f(sink[hq] * 1.4426950408889634f) : 0.f;
    int jlo = (q0 - 128) >> 6; if (jlo < 0) jlo = 0; int jhi = (q0 + 31 + 128) >> 6; if (jhi > 127) jhi = 127; const int nt = jhi - jlo + 2;
    const bf16_t* ksrc_u = KB + kv0 * 128 + wid * 8; const unsigned koff = (unsigned)lane * 128u;
    const bf16_t* vsrc_u = VB + (kv0 + (wid & 3) * 16) * 128 + (wid >> 2) * 32; const unsigned voff = (unsigned)(lane >> 2) * 128u + (unsigned)(lane & 3) * 8u;
#define ksrc (ksrc_u + koff)
#define vsrc (vsrc_u + voff)
    u32x4 k0r, k1r, v0r, v1r;
    { const size_t adv = (size_t)jlo * 64 * 128; k0r = *(const u32x4*)(ksrc + adv); k1r = *(const u32x4*)(ksrc + adv + 64); v0r = *(const u32x4*)(vsrc + adv); v1r = *(const u32x4*)(vsrc + adv + 64); }
    *(ATT_LAS u32x4*)(lds + wid * 1024 + lane * 16) = k0r; *(ATT_LAS u32x4*)(lds + 8192 + wid * 1024 + lane * 16) = k1r;
    *(ATT_LAS u32x4*)(lds + 16384 + tid * 16) = v0r; *(ATT_LAS u32x4*)(lds + 24576 + tid * 16) = v1r;
    __syncthreads();
#pragma unroll 1
    for (int i = 0; i < nt; ++i) {
        const int j = (i < nt - 1) ? jlo + i : 128; const int buf = i & 1;
        if (i + 1 < nt) { const int jn = (i + 1 < nt - 1) ? jlo + i + 1 : 128; const size_t adv = (size_t)jn * 64 * 128;
            k0r = *(const u32x4*)(ksrc + adv); k1r = *(const u32x4*)(ksrc + adv + 64); v0r = *(const u32x4*)(vsrc + adv); v1r = *(const u32x4*)(vsrc + adv + 64); }
        { f32x16 p0, p1;
            qkt(p0, p1, (lds_cptr)(lds + buf * 32768 + hk * 8192), qr, r32, hi); asm volatile("s_nop 15\n\ts_nop 15" : "+v"(p0), "+v"(p1));
            if (j == 128) {
#pragma unroll
                for (int r = 0; r < 16; ++r) { if (r >= 8) p0[r] = NEG_INF; p1[r] = NEG_INF; }
            } else if (!(64 * j + 63 <= q0 + 128 && 64 * j >= q0 - 97)) { const int dq = 64 * j - (q0 + r32);
#pragma unroll
                for (int r = 0; r < 16; ++r) { const int d0_ = dq + crow(r, hi), d1_ = d0_ + 32;
                    if (d0_ > 128 || d0_ < -128) p0[r] = NEG_INF; if (d1_ > 128 || d1_ < -128) p1[r] = NEG_INF; } }
            softmax_pv<2>(p0, p1, mref, l, o, (int)(lds0 + buf * 32768 + 16384 + hk * 8192) + vlane, r32, wsf, wsh);
        }
        if (i + 1 < nt) { const int nb = buf ^ 1;
            *(ATT_LAS u32x4*)(lds + nb * 32768 + wid * 1024 + lane * 16) = k0r; *(ATT_LAS u32x4*)(lds + nb * 32768 + 8192 + wid * 1024 + lane * 16) = k1r;
            *(ATT_LAS u32x4*)(lds + nb * 32768 + 16384 + tid * 16) = v0r; *(ATT_LAS u32x4*)(lds + nb * 32768 + 24576 + tid * 16) = v1r; }
        __syncthreads();
    }
#undef ksrc
#undef vsrc
    ATT_LAS float* ssx = (ATT_LAS float*)(lds + 65536);
    { const float lt = l + __shfl_xor(l, 32); const float il = 1.0f / lt;
        wsf[r32] = il;
#pragma unroll
        for (int r = 0; r < 16; ++r) { const float rl = wsh[(r & 3) + 8 * (r >> 2)]; o[0][r] *= rl; o[1][r] *= rl;
            float q = o[0][r] * o[0][r] + o[1][r] * o[1][r];
            q += __shfl_xor(q, 1); q += __shfl_xor(q, 2); q += __shfl_xor(q, 4); q += __shfl_xor(q, 8); q += __shfl_xor(q, 16);
            if (r32 == 0) ssx[wid * 32 + crow(r, hi)] = q; } }
    __syncthreads();
    __hip_bfloat16* wbase = (__hip_bfloat16*)ATT + (m0 + 4 * hi) * 1024 + 512 + hq * 64 + r32; asm volatile("" : "+v"(wbase));
#pragma unroll
    for (int r = 0; r < 16; ++r) { const int rr = crow(r, hi); float tot = 0.f;
#pragma unroll
        for (int w = 0; w < 8; ++w) tot += ssx[w * 32 + rr];
        const float rs = __builtin_amdgcn_rsqf(tot * (1.0f / 512.0f) + 1e-6f);
        __hip_bfloat16* orow = wbase + (size_t)((r & 3) + 8 * (r >> 2)) * 1024;
        orow[0] = __float2bfloat16(o[0][r] * rs); orow[32] = __float2bfloat16(o[1][r] * rs); }
    __syncthreads();
}
#undef SBAR
}
constexpr int NWAVES = 8;
constexpr int BATCH = 4, SEQ = 8192, DM = 1024, NMETA = 16, DFF = 2816, INW = 2304, LTOT = SEQ + NMETA;
constexpr int M = BATCH * SEQ;
constexpr int KVROWS = att::KVROWS;
constexpr size_t MiB = 1u << 20;
constexpr size_t WS_SS = 0;
constexpr size_t WS_SSM = 4 * (size_t)M * 4;
constexpr size_t WS_META = 1 * MiB;
constexpr size_t WS_ROPE = 2 * MiB;
constexpr size_t WS_WGU1 = 5 * MiB, WS_WD1 = 16 * MiB, WS_WIN = 22 * MiB, WS_WOUT = 27 * MiB, WS_WGU2 = 29 * MiB, WS_WD2 = 40 * MiB;
constexpr size_t WS_XB = 46 * MiB;
constexpr size_t WS_ATT = 110 * MiB;
constexpr size_t WS_HID = 174 * MiB;
constexpr size_t WS_QA = 174 * MiB, WS_QB = 206 * MiB, WS_KA = 238 * MiB, WS_VA = 271 * MiB, WS_KB = 304 * MiB, WS_VB = 313 * MiB;
constexpr size_t WS_END = 350 * MiB;
static_assert(WS_KA + (size_t)BATCH * KVROWS * 512 * 2 <= WS_VA && WS_VA + (size_t)BATCH * KVROWS * 512 * 2 <= WS_KB && WS_KB + (size_t)BATCH * KVROWS * 128 * 2 <= WS_VB && WS_VB + (size_t)BATCH * KVROWS * 128 * 2 <= WS_END, "qkv map");
static_assert(WS_HID + (size_t)M * DFF * 2 <= WS_END && (size_t)LTOT * 64 * 4 <= 3 * MiB && WS_SSM + 256 <= WS_META, "ws map");
constexpr int LDS_BYTES = 147456;
#define LAS __attribute__((address_space(3)))
typedef unsigned short bf16;
typedef unsigned v4u __attribute__((ext_vector_type(4)));
typedef float f32x4 __attribute__((ext_vector_type(4)));
typedef short bf16x8 __attribute__((ext_vector_type(8)));
__device__ __forceinline__ unsigned f2bf(float f) { unsigned u = __builtin_bit_cast(unsigned, f); return (u + 0x7fffu + ((u >> 16) & 1u)) >> 16; }
__device__ __forceinline__ unsigned pk2(float lo, float hi) { return f2bf(lo) | (f2bf(hi) << 16); }
__device__ __forceinline__ float wave_sum(float v) {
#pragma unroll
    for (int o = 1; o < 64; o <<= 1) v += __shfl_xor(v, o);
    return v;
}
template <int RM> __device__ __forceinline__ int map_row(int n) {
    if (RM == 1) return (n >> 7) * 256 + (n & 127);
    if (RM == 2) return (n >> 7) * 256 + 128 + (n & 127);
    if (RM == 3) { const int t = n >> 8, r = n & 255, hl = r >> 6, e = r & 63; return t * 256 + (e >> 5) * 128 + hl * 32 + (e & 31); }
    return n;
}
template <int RM, int GM> __device__ __forceinline__ void p0_transpose_item(const float* W, int K, int N, bf16* WT, const float* g, const float* g2, LAS float* scr, int item, int lane) {
    const int nblk = N / 32, kb = item / nblk, nb = item % nblk, k0 = 64 * kb, n0 = 32 * nb;
    float wv[32];
#pragma unroll
    for (int i = 0; i < 32; ++i) wv[i] = __builtin_nontemporal_load(W + (size_t)(k0 + 2 * i + (lane >> 5)) * N + n0 + (lane & 31));
    float gv0 = 1.f, gv1 = 1.f;
    if (GM == 1) gv0 = g[k0 + lane];
    if (GM == 2) { const int k = k0 + lane; gv0 = (k < 512) ? g[k & 127] * 0.8f : g2[k - 512]; }
    (void)gv1;
#pragma unroll
    for (int i = 0; i < 32; ++i) { const int kk = 2 * i + (lane >> 5); const float gv = (GM == 0) ? 1.f : __shfl(gv0, kk);
        scr[kk * 33 + (lane & 31)] = wv[i] * gv; }
    asm volatile("s_waitcnt lgkmcnt(0)" ::: "memory");
    const int c = lane & 7;
#pragma unroll
    for (int j = 0; j < 4; ++j) { const int n = (lane >> 3) + 8 * j; const LAS float* s = scr + (8 * c) * 33 + n;
        v4u o; o.x = pk2(s[0 * 33], s[1 * 33]); o.y = pk2(s[2 * 33], s[3 * 33]); o.z = pk2(s[4 * 33], s[5 * 33]); o.w = pk2(s[6 * 33], s[7 * 33]);
        *(v4u*)(WT + (size_t)map_row<RM>(n0 + n) * K + k0 + 8 * c) = o; }
    asm volatile("s_waitcnt lgkmcnt(0)" ::: "memory");
}
__device__ __forceinline__ void row_to_bf16_ss(const float* xrow, bf16* orow, float* ssp, int lane) {
    const f32x4* xr = (const f32x4*)xrow + lane; f32x4 v[4]; float s = 0.f;
#pragma unroll
    for (int j = 0; j < 4; ++j) { v[j] = xr[64 * j]; s += (v[j].x * v[j].x + v[j].y * v[j].y) + (v[j].z * v[j].z + v[j].w * v[j].w); }
    s = wave_sum(s);
    unsigned long long* o8 = (unsigned long long*)orow + lane;
#pragma unroll
    for (int j = 0; j < 4; ++j) o8[64 * j] = (unsigned long long)pk2(v[j].x, v[j].y) | ((unsigned long long)pk2(v[j].z, v[j].w) << 32);
    if (lane == 0) *ssp = s;
}
__device__ __forceinline__ void meta_mma2(const bf16* A, const bf16* Bt0, const bf16* Bt1, int K, f32x4& c0, f32x4& c1, int lane) {
    const int fr = lane & 15, fq = lane >> 4; c0 = (f32x4){0.f, 0.f, 0.f, 0.f}; c1 = c0;
    const bf16* ap = A + (size_t)fr * K + 8 * fq; const bf16* b0p = Bt0 + (size_t)fr * K + 8 * fq; const bf16* b1p = Bt1 + (size_t)fr * K + 8 * fq;
#pragma unroll 4
    for (int k0 = 0; k0 < K; k0 += 32) { const bf16x8 a = *(const bf16x8*)(ap + k0), b0 = *(const bf16x8*)(b0p + k0), b1 = *(const bf16x8*)(b1p + k0);
        c0 = __builtin_amdgcn_mfma_f32_16x16x32_bf16(b0, a, c0, 0, 0, 0); c1 = __builtin_amdgcn_mfma_f32_16x16x32_bf16(b1, a, c1, 0, 0, 0); }
}

#define ss0 ((float*)(args.ws + WS_SS))
#define ss1 (ss0 + M)
#define ss2 (ss0 + 2 * M)
#define ss3 (ss0 + 3 * M)
#define ssm0 ((float*)(args.ws + WS_SSM))
#define ssm1 (ssm0 + 16)
#define metab ((bf16*)(args.ws + WS_META))
#define hidm (metab + 16 * 1024)
#define h1mb (hidm + 16 * DFF)
#define rope ((float*)(args.ws + WS_ROPE))
#define WGU1 ((bf16*)(args.ws + WS_WGU1))
#define WD1 ((bf16*)(args.ws + WS_WD1))
#define WIN ((bf16*)(args.ws + WS_WIN))
#define WOUT ((bf16*)(args.ws + WS_WOUT))
#define WGU2 ((bf16*)(args.ws + WS_WGU2))
#define WD2 ((bf16*)(args.ws + WS_WD2))
#define XB ((bf16*)(args.ws + WS_XB))
#define ATT ((bf16*)(args.ws + WS_ATT))
#define HID ((bf16*)(args.ws + WS_HID))
#define QA ((bf16*)(args.ws + WS_QA))
#define QBW ((bf16*)(args.ws + WS_QB))
#define KA ((bf16*)(args.ws + WS_KA))
#define VA ((bf16*)(args.ws + WS_VA))
#define KB ((bf16*)(args.ws + WS_KB))
#define VB ((bf16*)(args.ws + WS_VB))
#define RLX_AGENT __ATOMIC_RELAXED, __HIP_MEMORY_SCOPE_AGENT
constexpr size_t WS_BAR = 1 * MiB + 512 * 1024;
constexpr int BAR_ZERO_BYTES = 16384;
constexpr int MISC_OFF = LDS_BYTES - 64;
#define XB_TMO      128
#define XB_XCNT(j)  (256  + 64 * (j))
#define XB_XSUB(j)  (1280 + 64 * (j))
#define XB_XGEN(j)  (2304 + 64 * (j))
#define XB_TOP      3328
#define XB_TOPGEN   3392
#define XCD_BAR_WORDS 3456
#define XB_SPIN_CAP (1u << 18)

__device__ __forceinline__ unsigned xb_ld(unsigned* p)              { return __hip_atomic_load(p, __ATOMIC_RELAXED, __HIP_MEMORY_SCOPE_AGENT); }
__device__ __forceinline__ unsigned xb_add(unsigned* p, unsigned v) { return __hip_atomic_fetch_add(p, v, __ATOMIC_RELAXED, __HIP_MEMORY_SCOPE_AGENT); }
__device__ __forceinline__ unsigned xb_xcc_id() { return (unsigned)__builtin_amdgcn_s_getreg((3 << 11) | 20) & 0xFu; }
#define XB_SPIN(cond, bar) do { unsigned _sp = 0; while (cond) { __builtin_amdgcn_s_sleep(1); \
    if ((++_sp & 255u) == 0u) { if (xb_ld(&(bar)[XB_TMO])) break; if (_sp > XB_SPIN_CAP) { atomicAdd(&(bar)[XB_TMO], 1u); break; } } } } while (0)

struct XcdBarrier {
    unsigned* bar; unsigned x;
    volatile LAS unsigned* st;
};

__device__ __forceinline__ XcdBarrier xcd_barrier_post(unsigned* bar, volatile LAS unsigned* st, bool leader) {
    XcdBarrier b; b.bar = bar; b.x = xb_xcc_id(); b.st = st;
    if (leader) (void)xb_add(&bar[XB_XCNT(b.x)], 1u);
    return b;
}
__device__ __forceinline__ void xcd_barrier_complete(unsigned* bar, unsigned x, unsigned& nloc, unsigned& nx) {
    const unsigned G = gridDim.x * gridDim.y * gridDim.z;
    unsigned sum, cnt, mine, sp = 0u;
    for (;;) {
        sum = 0u; cnt = 0u; mine = 0u;
#pragma unroll
        for (unsigned j = 0; j < 16; ++j) { const unsigned c = xb_ld(&bar[XB_XCNT(j)]); sum += c; cnt += (c > 0u) ? 1u : 0u; mine = (j == x) ? c : mine; }
        if (sum == G) break;
        __builtin_amdgcn_s_sleep(1);
        if ((++sp & 255u) == 0u) { if (xb_ld(&bar[XB_TMO])) break; if (sp > XB_SPIN_CAP) { atomicAdd(&bar[XB_TMO], 1u); break; } }
    }
    nloc = mine > 0u ? mine : 1u; nx = cnt > 0u ? cnt : 1u;
}

__device__ __forceinline__ void xcd_barrier(const XcdBarrier& b, bool leader) {
    asm volatile("s_waitcnt vmcnt(0)" ::: "memory");
    __syncthreads();
    if (leader) {
        unsigned* bar = b.bar;
        __builtin_amdgcn_s_waitcnt(0);
        unsigned nloc = b.st[0], nx = b.st[1];
        if (nloc == 0u) { xcd_barrier_complete(bar, b.x, nloc, nx); b.st[0] = nloc; b.st[1] = nx; }
        const unsigned old = xb_add(&bar[XB_XSUB(b.x)], 1u);
        const unsigned gen = old / nloc;
        if (old + 1u == (gen + 1u) * nloc) {
            __builtin_amdgcn_fence(__ATOMIC_RELEASE, "agent");
            asm volatile("s_waitcnt vmcnt(0)" ::: "memory");
            const unsigned og = xb_add(&bar[XB_TOP], 1u);
            const unsigned tg = og / nx;
            if (og + 1u == (tg + 1u) * nx) xb_add(&bar[XB_TOPGEN], 1u);
            else XB_SPIN(xb_ld(&bar[XB_TOPGEN]) == tg, bar);
            __builtin_amdgcn_fence(__ATOMIC_ACQUIRE, "agent");
            xb_add(&bar[XB_XGEN(b.x)], 1u);
            asm volatile("s_waitcnt vmcnt(0)" ::: "memory");
        } else {
            XB_SPIN(xb_ld(&bar[XB_XGEN(b.x)]) == gen, bar);
            __builtin_amdgcn_fence(__ATOMIC_ACQUIRE, "agent");
            asm volatile("s_waitcnt vmcnt(0)" ::: "memory");
        }
    }
    __syncthreads();
}

struct Args { const float* in[21]; float* out; unsigned char* ws; int ph_lo, ph_hi; };
constexpr int N_PHASES = 9;

__global__ void __launch_bounds__(NWAVES * 64, 2) hymba_fwd(Args args) {
    extern __shared__ __attribute__((aligned(16))) unsigned char lds[];
    __builtin_assume(__builtin_amdgcn_workitem_id_y() == 0); __builtin_assume(__builtin_amdgcn_workitem_id_z() == 0);
    LAS unsigned char* L = (LAS unsigned char*)lds;
    const int wave0 = __builtin_amdgcn_readfirstlane((int)threadIdx.x >> 6);
    const int G = gridDim.x; const int bx = blockIdx.x; const int vcu = (G % 8 == 0) ? (bx % 8) * (G / 8) + bx / 8 : bx;
    const int NGW = G * NWAVES, NGT = G * NWAVES * 64;
#define PHASE_IDS const int lane = (int)__builtin_amdgcn_mbcnt_hi(~0u, __builtin_amdgcn_mbcnt_lo(~0u, 0u)); const int wave = wave0; const int tid = wave * 64 + lane; \
    const int gw = vcu * NWAVES + wave; const int gtid = vcu * (NWAVES * 64) + tid; (void)lane; (void)gw; (void)gtid;
    const float* const x = args.in[0]; float* const out = args.out;
    const int lo = args.ph_lo, hi_ = args.ph_hi;
    XcdBarrier xbar; xbar.bar = (unsigned*)(args.ws + WS_BAR); xbar.x = 0; xbar.st = nullptr;
    const bool one_launch = (lo == 0 && hi_ == N_PHASES);
    if (one_launch) {
        const int lane0 = (int)__builtin_amdgcn_mbcnt_hi(~0u, __builtin_amdgcn_mbcnt_lo(~0u, 0u)); const bool leader0 = (wave0 == 0 && lane0 == 0);
        volatile LAS unsigned* st = (volatile LAS unsigned*)(L + MISC_OFF);
        if (leader0) { st[0] = 0u; st[1] = 0u; }
        __syncthreads();
        xbar = xcd_barrier_post((unsigned*)(args.ws + WS_BAR), st, leader0);
    }
#ifndef PHMASK
#define PHMASK 0x1ff
#endif
#define IN(k) (((PHMASK >> (k)) & 1) && lo <= (k) && (k) < hi_)
#define SEAM(k) do { if (IN(k) && IN((k) + 1)) { if (lo < 0) cg::this_grid().sync();     \
        const int lane_ = (int)__builtin_amdgcn_mbcnt_hi(~0u, __builtin_amdgcn_mbcnt_lo(~0u, 0u)); xcd_barrier(xbar, wave0 == 0 && lane_ == 0); } } while (0)

    if (IN(0)) { PHASE_IDS
        LAS float* scr = (LAS float*)(L + wave * 16384);
        constexpr int I_GU = (DM / 64) * (DFF / 32), I_DN = (DFF / 64) * (DM / 32), I_IN = (DM / 64) * (INW / 32), I_OUT = (DM / 64) * (DM / 32);
        constexpr int NITEMS = 4 * I_GU + 2 * I_DN + I_IN + I_OUT;
        for (int it = gw; it < NITEMS; it += NGW) {
            int r = it;
            if (r < I_GU) { p0_transpose_item<1, 1>(args.in[3], DM, DFF, WGU1, args.in[2], nullptr, scr, r, lane); continue; } r -= I_GU;
            if (r < I_GU) { p0_transpose_item<2, 1>(args.in[4], DM, DFF, WGU1, args.in[2], nullptr, scr, r, lane); continue; } r -= I_GU;
            if (r < I_GU) { p0_transpose_item<1, 1>(args.in[17], DM, DFF, WGU2, args.in[16], nullptr, scr, r, lane); continue; } r -= I_GU;
            if (r < I_GU) { p0_transpose_item<2, 1>(args.in[18], DM, DFF, WGU2, args.in[16], nullptr, scr, r, lane); continue; } r -= I_GU;
            if (r < I_DN) { p0_transpose_item<0, 0>(args.in[5], DFF, DM, WD1, nullptr, nullptr, scr, r, lane); continue; } r -= I_DN;
            if (r < I_DN) { p0_transpose_item<0, 0>(args.in[19], DFF, DM, WD2, nullptr, nullptr, scr, r, lane); continue; } r -= I_DN;
            if (r < I_IN) { p0_transpose_item<3, 1>(args.in[7], DM, INW, WIN, args.in[6], nullptr, scr, r, lane); continue; } r -= I_IN;
            p0_transpose_item<0, 2>(args.in[15], DM, DM, WOUT, args.in[12], args.in[14], scr, r, lane);
        }
        for (int m = gw; m < M; m += NGW) row_to_bf16_ss(x + (size_t)m * DM, XB + (size_t)m * DM, ss0 + m, lane);
        if (gw < 16) row_to_bf16_ss(args.in[1] + (size_t)gw * DM, metab + (size_t)gw * DM, ssm0 + gw, lane);
        for (int i = gtid; i < 3 * M; i += NGT) ss1[i] = 0.f;
        if (gtid < 16) ssm1[gtid] = 0.f;
        for (int i = gtid; i < LTOT * 32; i += NGT) { const int pos = i >> 5, k = i & 31;
            const float inv = exp2f(-(float)k * (13.287712379549449f / 32.0f)); const float ang = (float)pos * inv;
            rope[(size_t)pos * 64 + k] = cosf(ang); rope[(size_t)pos * 64 + 32 + k] = sinf(ang); }
    }
    SEAM(0);
    if (IN(1)) { PHASE_IDS
        if (gw < DFF / 16) { const int j = gw, t = j >> 3, within = (j & 7) * 16; const bf16* B0 = WGU1 + (size_t)(t * 256 + within) * DM; f32x4 c0, c1;
            meta_mma2(metab, B0, B0 + (size_t)128 * DM, DM, c0, c1, lane);
            const int fr = lane & 15, fq = lane >> 4; const float rs = pg8::rstd1024(ssm0[fr]);
#pragma unroll
            for (int e = 0; e < 4; ++e) hidm[(size_t)fr * DFF + j * 16 + 4 * fq + e] = (bf16)f2bf(pg8::silu_mul(c0[e] * rs, c1[e] * rs)); }
        pg8::Gemm g{XB, WGU1, M, 2 * DFF, DM}; pg8::StaticOrder S; S.init(M, 2 * DFF, G, bx);
        pg8::EpiSwiGLU E{HID, DFF, ss0};
        pg8::gemm_phase<pg8::EpiSwiGLU, pg8::StaticOrder, true, true>(L, g, S, E, tid);
    }
    SEAM(1);
    if (IN(2)) { PHASE_IDS
        if (gw < DM / 16) { const int n0 = gw * 16; f32x4 c0, c1; const bf16* B0 = WD1 + (size_t)n0 * DFF;
            meta_mma2(hidm, B0, B0, DFF, c0, c1, lane);
            const int fr = lane & 15, fq = lane >> 4; float q = 0.f;
#pragma unroll
            for (int e = 0; e < 4; ++e) { const int n = n0 + 4 * fq + e; const float v = args.in[1][(size_t)fr * DM + n] + 0.5f * c0[e]; h1mb[(size_t)fr * DM + n] = (bf16)f2bf(v); q += v * v; }
            q += __shfl_xor(q, 16); q += __shfl_xor(q, 32);
            if (fq == 0) __hip_atomic_fetch_add(ssm1 + fr, q, __ATOMIC_RELAXED, __HIP_MEMORY_SCOPE_AGENT); }
        pg8::Gemm g{HID, WD1, M, DM, DFF}; pg8::StaticOrder S; S.init(M, DM, G, bx);
        pg8::EpiResid<true> E{x, out, XB, ss1, 0.5f, DM};
        pg8::gemm_phase<pg8::EpiResid<true>, pg8::StaticOrder, true, true>(L, g, S, E, tid);
    }
    SEAM(2);
    if (IN(3)) { PHASE_IDS
        if (gw < 40) { const int ti = gw >> 3, j = gw & 7, t = (ti < 4) ? ti + 2 : 8, hl = j >> 1, i0 = (j & 1) * 16; f32x4 c0, c1;
            const bf16* B0 = WIN + (size_t)(t * 256 + hl * 32 + i0) * DM; meta_mma2(h1mb, B0, B0 + (size_t)128 * DM, DM, c0, c1, lane);
            const int fr = lane & 15, fq = lane >> 4, i = i0 + 4 * fq; const float rs = pg8::rstd1024(ssm1[fr]);
            bf16* dst; int ld, col; bool do_rope;
            if (t < 4) { dst = KA; ld = 512; col = ((t - 2) * 4 + hl) * 64; do_rope = true; }
            else if (t < 6) { dst = VA; ld = 512; col = (t - 4) * 256 + hl * 64; do_rope = false; }
            else if (hl < 2) { dst = KB; ld = 128; col = hl * 64; do_rope = true; }
            else { dst = VB; ld = 128; col = (hl - 2) * 64; do_rope = false; }
            float x1[4], x2[4];
#pragma unroll
            for (int e = 0; e < 4; ++e) { x1[e] = c0[e] * rs; x2[e] = c1[e] * rs;
                if (do_rope) { const float cs = rope[(size_t)fr * 64 + i + e], sn = rope[(size_t)fr * 64 + 32 + i + e]; const float a = x1[e] * cs - x2[e] * sn, b_ = x2[e] * cs + x1[e] * sn; x1[e] = a; x2[e] = b_; } }
            const unsigned long long w1 = (unsigned long long)pk2(x1[0], x1[1]) | ((unsigned long long)pk2(x1[2], x1[3]) << 32), w2 = (unsigned long long)pk2(x2[0], x2[1]) | ((unsigned long long)pk2(x2[2], x2[3]) << 32);
            for (int b = 0; b < BATCH; ++b) { bf16* p = dst + ((size_t)b * KVROWS + SEQ + fr) * ld + col + i; *(unsigned long long*)p = w1; *(unsigned long long*)(p + 32) = w2; } }
        { constexpr int PA = BATCH * 48 * 512 / 8, PB = BATCH * 48 * 128 / 8;
            for (int i = gtid; i < 2 * PA + 2 * PB; i += NGT) { int r = i; bf16* base; int ld;
                if (r < PA) { base = KA; ld = 512; } else if ((r -= PA) < PA) { base = VA; ld = 512; } else if ((r -= PA) < PB) { base = KB; ld = 128; } else { r -= PB; base = VB; ld = 128; }
                const int per_row = ld / 8, rowi = r / per_row, cpiece = r % per_row, b = rowi / 48, pr = rowi % 48;
                *(v4u*)(base + ((size_t)b * KVROWS + LTOT + pr) * ld + cpiece * 8) = (v4u){0u, 0u, 0u, 0u}; } }
        pg8::Gemm g{XB, WIN, M, INW, DM}; pg8::StaticOrder S; S.init(M, INW, G, bx);
        pg8::EpiQKV E{QA, KA, VA, QBW, KB, VB, ss1, rope};
        pg8::gemm_phase<pg8::EpiQKV, pg8::StaticOrder, true, true>(L, g, S, E, tid);
    }
    SEAM(3);
    if (IN(4)) { PHASE_IDS
        float lam;
        { const float a = args.in[8][lane] * args.in[9][lane], b_ = args.in[10][lane] * args.in[11][lane]; lam = expf(wave_sum(a)) - expf(wave_sum(b_)) + 0.2f; }
        const unsigned lds0 = (unsigned)(uintptr_t)lds;
        const int NDU = BATCH * 4 * (SEQ / 256), NWU = BATCH * (SEQ / 32);
        { const int per = (NDU + G - 1) / G; for (int u = vcu * per; u < (vcu + 1) * per && u < NDU; ++u) { const int bh = u >> 5, qb = u & 31; att::diff_unit(bh >> 2, bh & 3, qb, QA, KA, VA, ATT, lam, (att::lds_ptr)L, lds0, tid); } }
        { const int per = (NWU + G - 1) / G; for (int u = vcu * per; u < (vcu + 1) * per && u < NWU; ++u) { att::win_unit(u >> 8, u & 255, QBW, KB, VB, ATT, args.in[13], (att::lds_ptr)L, lds0, tid); } }
    }
    SEAM(4);
    if (IN(5)) { PHASE_IDS
        pg8::Gemm g{ATT, WOUT, M, DM, DM}; pg8::StaticOrder S; S.init(M, DM, G, bx);
        pg8::EpiResid<true> E{out, out, XB, ss2, 1.0f, DM};
        pg8::gemm_phase<pg8::EpiResid<true>, pg8::StaticOrder, true, true>(L, g, S, E, tid);
    }
    SEAM(5);
    if (IN(6)) { PHASE_IDS
        pg8::Gemm g{XB, WGU2, M, 2 * DFF, DM}; pg8::StaticOrder S; S.init(M, 2 * DFF, G, bx);
        pg8::EpiSwiGLU E{HID, DFF, ss2};
        pg8::gemm_phase<pg8::EpiSwiGLU, pg8::StaticOrder, true, true>(L, g, S, E, tid);
    }
    SEAM(6);
    if (IN(7)) { PHASE_IDS
        pg8::Gemm g{HID, WD2, M, DM, DFF}; pg8::StaticOrder S; S.init(M, DM, G, bx);
        pg8::EpiResid<false> E{out, out, nullptr, ss3, 0.5f, DM};
        pg8::gemm_phase<pg8::EpiResid<false>, pg8::StaticOrder, true, true>(L, g, S, E, tid);
    }
    SEAM(7);
    if (IN(8)) { PHASE_IDS
        const f32x4* gn = (const f32x4*)args.in[20] + lane;
        f32x4 g4[4];
#pragma unroll
        for (int j = 0; j < 4; ++j) g4[j] = gn[64 * j];
        for (int m = gw; m < M; m += 2 * NGW) {
            const int m1 = (m + NGW < M) ? m + NGW : m; const float rs0 = pg8::rstd1024(ss3[m]), rs1 = pg8::rstd1024(ss3[m1]);
            f32x4* o0 = (f32x4*)(out + (size_t)m * DM) + lane; f32x4* o1 = (f32x4*)(out + (size_t)m1 * DM) + lane; f32x4 v0[4], v1[4];
#pragma unroll
            for (int j = 0; j < 4; ++j) { v0[j] = o0[64 * j]; v1[j] = o1[64 * j]; }
#pragma unroll
            for (int j = 0; j < 4; ++j) o0[64 * j] = v0[j] * rs0 * g4[j];
            if (m1 != m) {
#pragma unroll
                for (int j = 0; j < 4; ++j) o1[64 * j] = v1[j] * rs1 * g4[j]; } }
    }
#undef IN
#undef SEAM
}

extern "C" void kernel_launch(void* const* d_in, const int* in_sizes, int n_in, void* d_out, int out_size, void* d_ws, size_t ws_size, hipStream_t stream) {
    static int grid = 0;
    if (grid == 0) {
        if (n_in != 21 || out_size != M * DM || ws_size < WS_END) { fprintf(stderr, "kernel_launch: unexpected shapes (n_in %d out %d ws %zu)\n", n_in, out_size, ws_size); grid = -1; return; }
        int dev = 0, cus = 0, per_cu = 0;
        if (hipGetDevice(&dev) != hipSuccess || hipDeviceGetAttribute(&cus, hipDeviceAttributeMultiprocessorCount, dev) != hipSuccess) { grid = -1; return; }
        if (hipFuncSetAttribute((const void*)hymba_fwd, hipFuncAttributeMaxDynamicSharedMemorySize, LDS_BYTES) != hipSuccess) { fprintf(stderr, "kernel_launch: hipFuncSetAttribute failed\n"); grid = -1; return; }
        if (hipOccupancyMaxActiveBlocksPerMultiprocessor(&per_cu, (const void*)hymba_fwd, NWAVES * 64, LDS_BYTES) != hipSuccess || per_cu < 1) { fprintf(stderr, "kernel_launch: occupancy query says %d\n", per_cu); per_cu = 1; }
        (void)hipGetLastError();
        grid = cus;
    }
    if (grid < 0) return;
    Args a{};
    for (int i = 0; i < 21; ++i) a.in[i] = (const float*)d_in[i];
    a.out = (float*)d_out; a.ws = (unsigned char*)d_ws;
#if MK_ONE_LAUNCH
    a.ph_lo = 0; a.ph_hi = N_PHASES;
    if (hipMemsetAsync((char*)d_ws + WS_BAR, 0, BAR_ZERO_BYTES, stream) != hipSuccess) { fprintf(stderr, "kernel_launch: memset of the barrier words failed\n"); return; }
    void* kargs[] = {&a};
    hipError_t e = hipLaunchCooperativeKernel((const void*)hymba_fwd, dim3(grid), dim3(NWAVES * 64), kargs, LDS_BYTES, stream);
    if (e != hipSuccess) fprintf(stderr, "kernel_launch: cooperative launch failed: %s (grid %d)\n", hipGetErrorString(e), grid);
#else
    for (int p = 0; p < N_PHASES; ++p) { a.ph_lo = p; a.ph_hi = p + 1; hipLaunchKernelGGL(hymba_fwd, dim3(grid), dim3(NWAVES * 64), LDS_BYTES, stream, a); }
#endif
}
```

```cpp
#include <hip/hip_runtime.h>
#include <hip/hip_cooperative_groups.h>
#include <hip/hip_bf16.h>
#include <cstdio>
#include <cstdint>
namespace cg = cooperative_groups;
#ifndef MK_ONE_LAUNCH
#define MK_ONE_LAUNCH 1
#endif
namespace pg8 {
#define PG8_LAS __attribute__((address_space(3)))
typedef unsigned short bf16_t;
typedef short bf16x8 __attribute__((ext_vector_type(8)));
typedef float f32x4 __attribute__((ext_vector_type(4)));
typedef unsigned u32x4 __attribute__((ext_vector_type(4)));
constexpr int BM = 256, BK = 64, HALF = 128, HTB = HALF * BK * 2  , STAGE_BYTES = 8 * HTB, NXCD = 8, WGM = 8;

__host__ __device__ __forceinline__ int lds_byte(int r, int c) { const int st = (r >> 4) * 2 + (c >> 5), rr = r & 15, cc = c & 31, ob = rr * 64 + cc * 2; return st * 1024 + (ob ^ (((ob >> 9) & 1) << 5)); }
__host__ __device__ __forceinline__ void stage_rc(int b, int& R, int& C) { const int st = b / 1024, sb = b % 1024, swz = sb ^ (((sb >> 9) & 1) << 5); R = (st >> 1) * 16 + swz / 64; C = (st & 1) * 32 + (swz % 64) / 2; }
__host__ __device__ __forceinline__ int perm32(int rho) { const int n = rho >> 4, i = rho & 15; return 8 * (i >> 2) + 4 * n + (i & 3); }

struct Unit { int pm, pn; };
struct Gemm { const bf16_t* A; const bf16_t* Bt; int M, N, K; };

struct StaticOrder {
    int nM, nN, nwg, G, c;
    __host__ __device__ void init(int M, int N, int G_, int c_) { nM = M / BM; nN = N / BM; nwg = nM * nN; G = G_; c = c_; }
    __host__ __device__ bool next(int i, Unit& u) const {
        const long L = (long)i * G + c; if (L >= nwg) return false;
        int wgid = (int)L; { const int q = nwg / NXCD, r = nwg % NXCD, xcd = wgid % NXCD, off = wgid / NXCD; wgid = (xcd < r ? xcd * (q + 1) : r * (q + 1) + (xcd - r) * q) + off; }
        const int nig = WGM * nN, gid = wgid / nig, fm = gid * WGM, gsz = (nM - fm) < WGM ? (nM - fm) : WGM;
        u.pm = fm + ((wgid % nig) % gsz); u.pn = (wgid % nig) / gsz; return true;
    }
    __device__ __forceinline__ void a_ready(const Unit&) const {}
    __device__ __forceinline__ void done(const Unit&) const {}
};

__device__ __forceinline__ unsigned cvt_pk_bf16(float lo, float hi) { unsigned r; asm volatile("v_cvt_pk_bf16_f32 %0, %1, %2" : "=v"(r) : "v"(lo), "v"(hi)); return r; }
typedef float f32x2 __attribute__((ext_vector_type(2)));
constexpr float RMS_EPS = 1e-6f;
__device__ __forceinline__ float rstd1024(float ss) { return __builtin_amdgcn_rsqf(ss * (1.0f / 1024.0f) + RMS_EPS); }
__device__ __forceinline__ float silu_mul(float g, float u) { return g * __builtin_amdgcn_rcpf(1.0f + __builtin_amdgcn_exp2f(-1.4426950408889634f * g)) * u; }

struct EpiSwiGLU {
    static constexpr bool PERM = true, AFTER_DRAIN = false;
    bf16_t* H; int ldh; const float* ss;
    __device__ __forceinline__ void operator()(const f32x4 (&acc)[2][2][4][2], const Unit& u, int wr, int wc, int fr, int fq) const {
        const int row0 = u.pm * BM + wr * 64 + fr; const int col0 = u.pn * HALF + wc * 32 + 8 * fq;
        float v8[8];
#pragma unroll
        for (int i = 0; i < 8; ++i) v8[i] = ss[row0 + (i >> 2) * HALF + (i & 3) * 16];
#pragma unroll
        for (int ai = 0; ai < 2; ++ai)
#pragma unroll
            for (int m = 0; m < 4; ++m) { const int row = row0 + ai * HALF + m * 16; const float v = v8[ai * 4 + m] * (1.0f / 1024.0f) + RMS_EPS;
                const float rs = __builtin_amdgcn_rsqf(v); const float a = rs * -1.4426950408889634f;
                float h[8];
#pragma unroll
                for (int n = 0; n < 2; ++n)
#pragma unroll
                    for (int e = 0; e < 4; ++e) { const float g = acc[ai][0][m][n][e], uu = acc[ai][1][m][n][e];
                        const float ex = __builtin_amdgcn_exp2f(g * a); const float r = __builtin_amdgcn_rcpf(__builtin_fmaf(ex, v, v)); h[n * 4 + e] = (g * uu) * r; }
                u32x4 w; w.x = cvt_pk_bf16(h[0], h[1]); w.y = cvt_pk_bf16(h[2], h[3]); w.z = cvt_pk_bf16(h[4], h[5]); w.w = cvt_pk_bf16(h[6], h[7]);
                *(u32x4*)(H + (size_t)row * ldh + col0) = w; }
    }
};
typedef unsigned u32x2 __attribute__((ext_vector_type(2)));
template <bool WB> struct EpiResid {
    static constexpr bool PERM = true, AFTER_DRAIN = false;
    const float* base; float* out; bf16_t* outb; float* ssout; float alpha; int ldc;
    __device__ __forceinline__ void operator()(const f32x4 (&acc)[2][2][4][2], const Unit& u, int wr, int wc, int fr, int fq) const {
        const int row0 = u.pm * BM + wr * 64 + fr; const int col0 = u.pn * BM + wc * 32 + 8 * fq;
#pragma unroll
        for (int ai = 0; ai < 2; ++ai)
#pragma unroll
            for (int m = 0; m < 4; ++m) { const int row = row0 + ai * HALF + m * 16; const size_t off = (size_t)row * ldc + col0; float q = 0.f;
#pragma unroll
                for (int bj = 0; bj < 2; ++bj) { const f32x4 b0 = *(const f32x4*)(base + off + bj * HALF), b1 = *(const f32x4*)(base + off + bj * HALF + 4);
                    const f32x4 o0 = b0 + acc[ai][bj][m][0] * alpha, o1 = b1 + acc[ai][bj][m][1] * alpha;
                    *(f32x4*)(out + off + bj * HALF) = o0; *(f32x4*)(out + off + bj * HALF + 4) = o1;
                    q += (o0[0] * o0[0] + o0[1] * o0[1]) + (o0[2] * o0[2] + o0[3] * o0[3]) + (o1[0] * o1[0] + o1[1] * o1[1]) + (o1[2] * o1[2] + o1[3] * o1[3]);
                    if (WB) { u32x4 w; w.x = cvt_pk_bf16(o0[0], o0[1]); w.y = cvt_pk_bf16(o0[2], o0[3]); w.z = cvt_pk_bf16(o1[0], o1[1]); w.w = cvt_pk_bf16(o1[2], o1[3]); *(u32x4*)(outb + off + bj * HALF) = w; } }
                q += __shfl_xor(q, 16); q += __shfl_xor(q, 32);
                if (fq == 0) __hip_atomic_fetch_add(ssout + row, q, __ATOMIC_RELAXED, __HIP_MEMORY_SCOPE_AGENT); }
    }
};
constexpr float QK_C2 = 0.125f * 1.4426950408889634f;
struct EpiQKV {
    static constexpr bool PERM = true, AFTER_DRAIN = false;
    bf16_t *QA, *KA, *VA, *QBW, *KB, *VB; const float* ss; const float* rope;
    __device__ __forceinline__ void operator()(const f32x4 (&acc)[2][2][4][2], const Unit& u, int wr, int wc, int fr, int fq) const {
        const int t = u.pn, hl = wc, i0 = 8 * fq; const int row0 = u.pm * BM + wr * 64 + fr;
        bf16_t* dst; int ld, col; bool do_rope, kv; float sc = 1.f;
        if (t < 2) { dst = QA; ld = 512; col = (t * 4 + hl) * 64; do_rope = true; kv = false; sc = QK_C2; }
        else if (t < 4) { dst = KA; ld = 512; col = ((t - 2) * 4 + hl) * 64; do_rope = true; kv = true; }
        else if (t < 6) { dst = VA; ld = 512; col = (t - 4) * 256 + hl * 64; do_rope = false; kv = true; }
        else if (t < 8) { dst = QBW; ld = 512; col = ((t - 6) * 4 + hl) * 64; do_rope = true; kv = false; sc = QK_C2; }
        else if (hl < 2) { dst = KB; ld = 128; col = hl * 64; do_rope = true; kv = true; }
        else { dst = VB; ld = 128; col = (hl - 2) * 64; do_rope = false; kv = true; }
        float rs8[8];
#pragma unroll
        for (int i = 0; i < 8; ++i) rs8[i] = ss[row0 + (i >> 2) * HALF + (i & 3) * 16];
#pragma unroll
        for (int ai = 0; ai < 2; ++ai)
#pragma unroll
            for (int m = 0; m < 4; ++m) { const int row = row0 + ai * HALF + m * 16; const int b = row >> 13, s = row & 8191; const float rs = rstd1024(rs8[ai * 4 + m]);
                const size_t drow = kv ? (size_t)b * 8256 + s : (size_t)row;
                f32x4 x1a = acc[ai][0][m][0] * rs, x1b = acc[ai][0][m][1] * rs, x2a = acc[ai][1][m][0] * rs, x2b = acc[ai][1][m][1] * rs;
                if (do_rope) { const float* rp = rope + (size_t)(16 + s) * 64 + i0;
                    const f32x4 ca = *(const f32x4*)(rp), cb = *(const f32x4*)(rp + 4), sa = *(const f32x4*)(rp + 32), sb = *(const f32x4*)(rp + 36);
                    const f32x4 o1a = (x1a * ca - x2a * sa) * sc, o1b = (x1b * cb - x2b * sb) * sc, o2a = (x2a * ca + x1a * sa) * sc, o2b = (x2b * cb + x1b * sb) * sc;
                    x1a = o1a; x1b = o1b; x2a = o2a; x2b = o2b; }
                u32x4 w1, w2; w1.x = cvt_pk_bf16(x1a[0], x1a[1]); w1.y = cvt_pk_bf16(x1a[2], x1a[3]); w1.z = cvt_pk_bf16(x1b[0], x1b[1]); w1.w = cvt_pk_bf16(x1b[2], x1b[3]);
                w2.x = cvt_pk_bf16(x2a[0], x2a[1]); w2.y = cvt_pk_bf16(x2a[2], x2a[3]); w2.z = cvt_pk_bf16(x2b[0], x2b[1]); w2.w = cvt_pk_bf16(x2b[2], x2b[3]);
                bf16_t* p = dst + drow * ld + col + i0; *(u32x4*)p = w1; *(u32x4*)(p + 32) = w2; }
    }
};

template <class Epi, class Sched, bool ALIGN_EPI = false, bool SP2 = false>
__device__ __forceinline__ void gemm_phase(PG8_LAS unsigned char* lds, const Gemm g, const Sched& S, const Epi& E, const int tid) {
    const int wid = __builtin_amdgcn_readfirstlane(tid >> 6), lane = tid & 63, wr = wid >> 2, wc = wid & 3, fr = lane & 15, fq = lane >> 4;
    const int K = g.K, nt = K / BK;
    unsigned voffA[2], voffB[2];
#pragma unroll
    for (int i = 0; i < 2; ++i) { int R, C; stage_rc(tid * 16 + i * 8192, R, C); const int Rb = Epi::PERM ? ((R & ~31) + perm32(R & 31)) : R;
        voffA[i] = (unsigned)(R * K + C) * 2u; voffB[i] = (unsigned)(Rb * K + C) * 2u; }
    const size_t kstep = (size_t)(BK * 2);
    const size_t hstep = (size_t)HALF * K * 2;
    const size_t tstep = 2 * hstep;
    const unsigned ldsw = (unsigned)wid * 1024u;
    const int aoff = lds_byte(wr * 64 + fr, fq * 8), boff = lds_byte(wc * 32 + fr, fq * 8);
#define PG8_SA(b, h) (((b) * 2 + (h)) * HTB)
#define PG8_SB(b, h) ((4 + (b) * 2 + (h)) * HTB)
#define PG8_STAGE(bufoff, gbase, voff) do { _Pragma("unroll") for (int _i = 0; _i < 2; ++_i) \
        __builtin_amdgcn_global_load_lds((const unsigned*)((const char*)(gbase) + (voff)[_i]), (PG8_LAS unsigned*)(lds + (bufoff) + ldsw + _i * 8192), 16, 0, 0); } while (0)
#define PG8_LDA(dst, b, h) do { _Pragma("unroll") for (int m = 0; m < 4; ++m) _Pragma("unroll") for (int k = 0; k < 2; ++k) dst[m][k] = *(const PG8_LAS bf16x8*)(lds + PG8_SA(b, h) + aoff + m * 2048 + k * 1024); } while (0)
#define PG8_LDB(dst, b, h) do { _Pragma("unroll") for (int n = 0; n < 2; ++n) _Pragma("unroll") for (int k = 0; k < 2; ++k) dst[n][k] = *(const PG8_LAS bf16x8*)(lds + PG8_SB(b, h) + boff + n * 2048 + k * 1024); } while (0)
#define PG8_MMA(ai, bj, At, Bt) do { __builtin_amdgcn_s_setprio(1); _Pragma("unroll") for (int m = 0; m < 4; ++m) _Pragma("unroll") for (int n = 0; n < 2; ++n) _Pragma("unroll") for (int k = 0; k < 2; ++k) \
        acc[ai][bj][m][n] = __builtin_amdgcn_mfma_f32_16x16x32_bf16(Bt[n][k], At[m][k], acc[ai][bj][m][n], 0, 0, 0); __builtin_amdgcn_s_setprio(0); } while (0)
#define PG8_WAIT_V(n) asm volatile("s_waitcnt vmcnt(" #n ")" ::: "memory")
#define PG8_WAIT_L(n) asm volatile("s_waitcnt lgkmcnt(" #n ")" ::: "memory")
#define PG8_BAR __builtin_amdgcn_s_barrier()
#define PG8_SCHED __builtin_amdgcn_sched_barrier(0)
    Unit cur, nxt; int ui = 0;
    if (!S.next(0, cur)) return;
    f32x4 acc[2][2][4][2];
#pragma unroll
    for (int a = 0; a < 2; ++a)
#pragma unroll
        for (int b = 0; b < 2; ++b)
#pragma unroll
            for (int m = 0; m < 4; ++m)
#pragma unroll
                for (int n = 0; n < 2; ++n) acc[a][b][m][n] = (f32x4){0.f, 0.f, 0.f, 0.f};
    bf16x8 At[4][2], B0[2][2], B1[2][2];
    const char* cA = (const char*)g.A + (size_t)cur.pm * tstep; const char* cB = (const char*)g.Bt + (size_t)cur.pn * tstep;
    S.a_ready(cur);
    if constexpr (SP2) {
        PG8_STAGE(PG8_SB(0, 0), cB, voffB); PG8_STAGE(PG8_SB(0, 1), cB + hstep, voffB); PG8_STAGE(PG8_SA(0, 0), cA, voffA); PG8_STAGE(PG8_SA(0, 1), cA + hstep, voffA);
        if (wr == 1) PG8_BAR;
        PG8_WAIT_V(2); PG8_BAR;
        PG8_STAGE(PG8_SB(1, 0), cB + kstep, voffB); PG8_STAGE(PG8_SA(1, 0), cA + kstep, voffA); PG8_STAGE(PG8_SB(1, 1), cB + hstep + kstep, voffB);
        PG8_WAIT_V(6); PG8_BAR;
    } else {
        PG8_STAGE(PG8_SB(0, 0), cB, voffB); PG8_STAGE(PG8_SA(0, 0), cA, voffA); PG8_STAGE(PG8_SB(0, 1), cB + hstep, voffB); PG8_STAGE(PG8_SA(0, 1), cA + hstep, voffA);
        if (wr == 1) PG8_BAR;
        PG8_WAIT_V(4); PG8_BAR;
        PG8_STAGE(PG8_SB(1, 0), cB + kstep, voffB); PG8_STAGE(PG8_SA(1, 0), cA + kstep, voffA); PG8_STAGE(PG8_SB(1, 1), cB + hstep + kstep, voffB);
        PG8_WAIT_V(6); PG8_BAR;
    }
    for (;;) {
        const bool has_next = S.next(ui + 1, nxt);
        const char* nA = has_next ? (const char*)g.A + (size_t)nxt.pm * tstep : cA; const char* nB = has_next ? (const char*)g.Bt + (size_t)nxt.pn * tstep : cB;
        for (int t = 0; t < nt; t += 2) {
            const bool last = (t == nt - 2);
            const char* a1 = cA + (size_t)(t + 1) * kstep;
            const char* a2 = last ? nA : cA + (size_t)(t + 2) * kstep; const char* b2 = last ? nB : cB + (size_t)(t + 2) * kstep;
            const char* a3 = a2 + kstep; const char* b3 = b2 + kstep;
            if (last && has_next) S.a_ready(nxt);
            if constexpr (SP2) {
            PG8_LDB(B0, 0, 0); PG8_LDB(B1, 0, 1); PG8_SCHED; PG8_LDA(At, 0, 0); PG8_STAGE(PG8_SA(1, 1), a1 + hstep, voffA);
            PG8_WAIT_V(8); PG8_WAIT_L(0); PG8_BAR; PG8_MMA(0, 0, At, B0); PG8_MMA(0, 1, At, B1); PG8_BAR; PG8_SCHED;
            PG8_LDA(At, 0, 1); PG8_STAGE(PG8_SB(0, 0), b2, voffB); PG8_STAGE(PG8_SB(0, 1), b2 + hstep, voffB); PG8_STAGE(PG8_SA(0, 0), a2, voffA);
            PG8_WAIT_V(8); PG8_WAIT_L(0); PG8_BAR; PG8_MMA(1, 0, At, B0); PG8_MMA(1, 1, At, B1); PG8_BAR; PG8_SCHED;
            PG8_LDB(B0, 1, 0); PG8_LDB(B1, 1, 1); PG8_SCHED; PG8_LDA(At, 1, 0); PG8_STAGE(PG8_SA(0, 1), a2 + hstep, voffA);
            PG8_WAIT_V(8); PG8_WAIT_L(0); PG8_BAR; PG8_MMA(0, 0, At, B0); PG8_MMA(0, 1, At, B1); PG8_BAR; PG8_SCHED;
            PG8_LDA(At, 1, 1); PG8_STAGE(PG8_SB(1, 0), b3, voffB); PG8_STAGE(PG8_SB(1, 1), b3 + hstep, voffB); PG8_STAGE(PG8_SA(1, 0), a3, voffA);
            PG8_WAIT_V(8); PG8_WAIT_L(0); PG8_BAR; PG8_MMA(1, 0, At, B0); PG8_MMA(1, 1, At, B1); PG8_BAR; PG8_SCHED;
            } else {
            PG8_LDB(B0, 0, 0); PG8_SCHED; PG8_LDA(At, 0, 0); PG8_STAGE(PG8_SA(1, 1), a1 + hstep, voffA);
            PG8_WAIT_L(8); PG8_BAR; PG8_WAIT_L(0); PG8_MMA(0, 0, At, B0); PG8_BAR; PG8_SCHED;
            PG8_LDB(B1, 0, 1); PG8_STAGE(PG8_SB(0, 0), b2, voffB);
            PG8_BAR; PG8_WAIT_L(0); PG8_MMA(0, 1, At, B1); PG8_BAR;
            PG8_LDA(At, 0, 1); PG8_STAGE(PG8_SA(0, 0), a2, voffA);
            PG8_BAR; PG8_WAIT_L(0); PG8_MMA(1, 0, At, B0); PG8_BAR; PG8_SCHED;
            PG8_STAGE(PG8_SB(0, 1), b2 + hstep, voffB);
            PG8_WAIT_V(6); PG8_BAR; PG8_MMA(1, 1, At, B1); PG8_BAR;
            PG8_LDB(B0, 1, 0); PG8_SCHED; PG8_LDA(At, 1, 0); PG8_STAGE(PG8_SA(0, 1), a2 + hstep, voffA);
            PG8_WAIT_L(8); PG8_BAR; PG8_WAIT_L(0); PG8_MMA(0, 0, At, B0); PG8_BAR; PG8_SCHED;
            PG8_LDB(B1, 1, 1); PG8_STAGE(PG8_SB(1, 0), b3, voffB);
            PG8_BAR; PG8_WAIT_L(0); PG8_MMA(0, 1, At, B1); PG8_BAR;
            PG8_LDA(At, 1, 1); PG8_STAGE(PG8_SA(1, 0), a3, voffA);
            PG8_BAR; PG8_WAIT_L(0); PG8_MMA(1, 0, At, B0); PG8_BAR; PG8_SCHED;
            PG8_STAGE(PG8_SB(1, 1), b3 + hstep, voffB);
            PG8_WAIT_V(6); PG8_BAR; PG8_MMA(1, 1, At, B1); PG8_BAR;
            }
        }
        if constexpr (ALIGN_EPI) { if (wr == 0) PG8_BAR; }
        if constexpr (!Epi::AFTER_DRAIN) { E(acc, cur, wr, wc, fr, fq); S.done(cur); }
        if (!has_next) break;
#pragma unroll
        for (int a = 0; a < 2; ++a)
#pragma unroll
            for (int b = 0; b < 2; ++b)
#pragma unroll
                for (int m = 0; m < 4; ++m)
#pragma unroll
                    for (int n = 0; n < 2; ++n) acc[a][b][m][n] = (f32x4){0.f, 0.f, 0.f, 0.f};
        cur = nxt; cA = nA; cB = nB; ++ui;
        if constexpr (ALIGN_EPI) { if (wr == 1) PG8_BAR; }
    }
    PG8_WAIT_V(0);
    if constexpr (!ALIGN_EPI) { if (wr == 0) PG8_BAR; }
    PG8_BAR;
    if constexpr (Epi::AFTER_DRAIN) { E.fused(acc, cur, wr, wc, fr, fq, lds, wid, lane); S.done(cur); }
#undef PG8_SA
#undef PG8_SB
#undef PG8_STAGE
#undef PG8_LDA
#undef PG8_LDB
#undef PG8_MMA
#undef PG8_WAIT_V
#undef PG8_WAIT_L
#undef PG8_BAR
#undef PG8_SCHED
}
}
namespace att {
#define ATT_LAS __attribute__((address_space(3)))
typedef unsigned short bf16_t;
typedef short bf16x8 __attribute__((ext_vector_type(8)));
typedef short s16x4 __attribute__((ext_vector_type(4)));
typedef float f32x16 __attribute__((ext_vector_type(16)));
typedef unsigned u32x4 __attribute__((ext_vector_type(4)));
typedef float f32x2_t __attribute__((ext_vector_type(2))); typedef __bf16 bf16x2_t __attribute__((ext_vector_type(2)));
#define SBAR() __builtin_amdgcn_sched_barrier(0)
__device__ __forceinline__ int crow(int r, int hi) { return (r & 3) + 8 * (r >> 2) + 4 * hi; }
__device__ __forceinline__ unsigned cvtpk_s(float lo, float hi) { f32x2_t v = {lo, hi}; bf16x2_t b = __builtin_convertvector(v, bf16x2_t); return __builtin_bit_cast(unsigned, b); }
__device__ __forceinline__ float bf_lo(unsigned w) { return __uint_as_float(w << 16); }
__device__ __forceinline__ float bf_hi(unsigned w) { return __uint_as_float(w & 0xffff0000u); }
typedef ATT_LAS const char* lds_cptr;
typedef ATT_LAS char* lds_ptr;
__device__ __forceinline__ void qkt(f32x16& p0, f32x16& p1, lds_cptr Kslot, const bf16x8* qr, int r32, int hi) {
    const f32x16 negm = {0.f,0.f,0.f,0.f,0.f,0.f,0.f,0.f,0.f,0.f,0.f,0.f,0.f,0.f,0.f,0.f};
    lds_cptr kb = Kslot + hi * 1024 + r32 * 16;
#pragma unroll
    for (int d0 = 0; d0 < 4; ++d0) {
        const bf16x8 b0 = *(const ATT_LAS bf16x8*)(kb + d0 * 2048);
        const bf16x8 b1 = *(const ATT_LAS bf16x8*)(kb + d0 * 2048 + 512);
        if (d0 == 0) { p0 = __builtin_amdgcn_mfma_f32_32x32x16_bf16(b0, qr[0], negm, 0, 0, 0); p1 = __builtin_amdgcn_mfma_f32_32x32x16_bf16(b1, qr[0], negm, 0, 0, 0); }
        else { p0 = __builtin_amdgcn_mfma_f32_32x32x16_bf16(b0, qr[d0], p0, 0, 0, 0); p1 = __builtin_amdgcn_mfma_f32_32x32x16_bf16(b1, qr[d0], p1, 0, 0, 0); } }
}
__device__ __forceinline__ float rowmax(const f32x16& p0, const f32x16& p1) {
    float a = __builtin_fmaxf(p0[0], p1[0]), b = __builtin_fmaxf(p0[1], p1[1]);
#pragma unroll
    for (int r = 2; r < 16; r += 2) { a = __builtin_fmaxf(a, __builtin_fmaxf(p0[r], p1[r])); b = __builtin_fmaxf(b, __builtin_fmaxf(p0[r + 1], p1[r + 1])); }
    const float m = __builtin_fmaxf(a, b);
    return __builtin_fmaxf(m, __shfl_xor(m, 32));
}
__device__ __forceinline__ float max3f(float a, float b, float c) { float r; asm("v_max3_f32 %0, %1, %2, %3" : "=v"(r) : "v"(a), "v"(b), "v"(c)); return r; }
__device__ __forceinline__ float max2f(float a, float b) { float r; asm("v_max_f32_e32 %0, %1, %2" : "=v"(r) : "v"(a), "v"(b)); return r; }
__device__ __forceinline__ float rowmax_fast(const f32x16& p0, const f32x16& p1) {
    float a = max3f(p0[0], p0[1], p1[0]), b = max3f(p0[2], p0[3], p1[1]); a = max3f(a, p1[2], p1[3]);
#pragma unroll
    for (int r = 4; r < 16; r += 4) { a = max3f(a, p0[r], p0[r + 1]); b = max3f(b, p0[r + 2], p0[r + 3]); a = max3f(a, p1[r], p1[r + 1]); b = max3f(b, p1[r + 2], p1[r + 3]); }
    const float m = max2f(a, b);
    auto rr = __builtin_amdgcn_permlane32_swap(__float_as_uint(m), __float_as_uint(m), false, false);
    return max2f(__uint_as_float(rr[0]), __uint_as_float(rr[1]));
}
template <int NDQ> __device__ __forceinline__ void pv(f32x16* o, int vb, bf16x8 pa0, bf16x8 pa1, bf16x8 pa2, bf16x8 pa3) {
#pragma unroll
    for (int d0 = 0; d0 < NDQ; ++d0) { s16x4 lo[4], hi[4];
#pragma unroll
        for (int ks = 0; ks < 4; ++ks) {
            asm volatile("ds_read_b64_tr_b16 %0,%1 offset:%c2" : "=&v"(lo[ks]) : "v"(vb), "i"(d0 * 4096 + ks * 1024) : "memory");
            asm volatile("ds_read_b64_tr_b16 %0,%1 offset:%c2" : "=&v"(hi[ks]) : "v"(vb), "i"(d0 * 4096 + ks * 1024 + 512) : "memory"); }
        asm volatile("s_waitcnt lgkmcnt(0)" ::: "memory"); SBAR();
#define ATT_PK(k) (bf16x8){lo[k][0], lo[k][1], lo[k][2], lo[k][3], hi[k][0], hi[k][1], hi[k][2], hi[k][3]}
        o[d0] = __builtin_amdgcn_mfma_f32_32x32x16_bf16(pa0, ATT_PK(0), o[d0], 0, 0, 0);
        o[d0] = __builtin_amdgcn_mfma_f32_32x32x16_bf16(pa1, ATT_PK(1), o[d0], 0, 0, 0);
        o[d0] = __builtin_amdgcn_mfma_f32_32x32x16_bf16(pa2, ATT_PK(2), o[d0], 0, 0, 0);
        o[d0] = __builtin_amdgcn_mfma_f32_32x32x16_bf16(pa3, ATT_PK(3), o[d0], 0, 0, 0);
#undef ATT_PK
    }
}
template <int NDQ> __device__ __forceinline__ void softmax_pv(f32x16& p0, f32x16& p1, float& mref, float& l, f32x16* o, int vb, int r32, ATT_LAS float* wsf, const ATT_LAS float* wsh) {
    const float rm = rowmax_fast(p0, p1) - mref;
    if (__any(rm > 8.0f)) {
        const float dl = __builtin_fmaxf(rm, 0.f); mref += dl;
        const float f = __builtin_amdgcn_exp2f(-dl); l *= f;
        wsf[r32] = f;
#pragma unroll
        for (int r = 0; r < 16; ++r) { const float fr_ = wsh[(r & 3) + 8 * (r >> 2)];
#pragma unroll
            for (int d = 0; d < NDQ; ++d) o[d][r] *= fr_; }
    }
    float s0 = 0.f, s1 = 0.f;
#pragma unroll
    for (int r = 0; r < 16; ++r) { p0[r] = __builtin_amdgcn_exp2f(p0[r] - mref); p1[r] = __builtin_amdgcn_exp2f(p1[r] - mref); s0 += p0[r]; s1 += p1[r]; }
    l += s0 + s1;
    u32x4 pw0, pw1, pw2, pw3;
    pw0 = (u32x4){cvtpk_s(p0[0], p0[1]), cvtpk_s(p0[2], p0[3]), cvtpk_s(p0[4], p0[5]), cvtpk_s(p0[6], p0[7])};
    pw1 = (u32x4){cvtpk_s(p0[8], p0[9]), cvtpk_s(p0[10], p0[11]), cvtpk_s(p0[12], p0[13]), cvtpk_s(p0[14], p0[15])};
    pw2 = (u32x4){cvtpk_s(p1[0], p1[1]), cvtpk_s(p1[2], p1[3]), cvtpk_s(p1[4], p1[5]), cvtpk_s(p1[6], p1[7])};
    pw3 = (u32x4){cvtpk_s(p1[8], p1[9]), cvtpk_s(p1[10], p1[11]), cvtpk_s(p1[12], p1[13]), cvtpk_s(p1[14], p1[15])};
    SBAR();
    pv<NDQ>(o, vb, __builtin_bit_cast(bf16x8, pw0), __builtin_bit_cast(bf16x8, pw1), __builtin_bit_cast(bf16x8, pw2), __builtin_bit_cast(bf16x8, pw3));
}
__device__ __forceinline__ f32x16 splat16(float v) { f32x16 x;
#pragma unroll
    for (int r = 0; r < 16; ++r) x[r] = v; return x; }
constexpr int KVROWS = 8256, NREAL = 8192, NKT = 129;
constexpr float NEG_INF = -__builtin_inff();

#ifndef ATT_NEGM
#define ATT_NEGM 0
#endif
#ifndef ATT_PVF
#define ATT_PVF pv2
#endif
template <int NDQ> __device__ __forceinline__ void pv2(f32x16* o, int vb, bf16x8 pa0, bf16x8 pa1, bf16x8 pa2, bf16x8 pa3) {
    s16x4 lo[2][4], hi[2][4];
#define ATT_RD(S, D) do { _Pragma("unroll") for (int ks = 0; ks < 4; ++ks) { \
        asm volatile("ds_read_b64_tr_b16 %0,%1 offset:%c2" : "=&v"(lo[S][ks]) : "v"(vb), "i"((D) * 4096 + ks * 1024) : "memory"); \
        asm volatile("ds_read_b64_tr_b16 %0,%1 offset:%c2" : "=&v"(hi[S][ks]) : "v"(vb), "i"((D) * 4096 + ks * 1024 + 512) : "memory"); } } while (0)
#define ATT_PK2(S, k) (bf16x8){lo[S][k][0], lo[S][k][1], lo[S][k][2], lo[S][k][3], hi[S][k][0], hi[S][k][1], hi[S][k][2], hi[S][k][3]}
    ATT_RD(0, 0);
#pragma unroll
    for (int d0 = 0; d0 < NDQ; ++d0) {
        if (d0 + 1 < NDQ) { if ((d0 & 1) == 0) ATT_RD(1, d0 + 1); else ATT_RD(0, d0 + 1); asm volatile("s_waitcnt lgkmcnt(8)" ::: "memory"); }
        else asm volatile("s_waitcnt lgkmcnt(0)" ::: "memory");
        SBAR();
        if ((d0 & 1) == 0) {
            o[d0] = __builtin_amdgcn_mfma_f32_32x32x16_bf16(pa0, ATT_PK2(0, 0), o[d0], 0, 0, 0); o[d0] = __builtin_amdgcn_mfma_f32_32x32x16_bf16(pa1, ATT_PK2(0, 1), o[d0], 0, 0, 0);
            o[d0] = __builtin_amdgcn_mfma_f32_32x32x16_bf16(pa2, ATT_PK2(0, 2), o[d0], 0, 0, 0); o[d0] = __builtin_amdgcn_mfma_f32_32x32x16_bf16(pa3, ATT_PK2(0, 3), o[d0], 0, 0, 0);
        } else {
            o[d0] = __builtin_amdgcn_mfma_f32_32x32x16_bf16(pa0, ATT_PK2(1, 0), o[d0], 0, 0, 0); o[d0] = __builtin_amdgcn_mfma_f32_32x32x16_bf16(pa1, ATT_PK2(1, 1), o[d0], 0, 0, 0);
            o[d0] = __builtin_amdgcn_mfma_f32_32x32x16_bf16(pa2, ATT_PK2(1, 2), o[d0], 0, 0, 0); o[d0] = __builtin_amdgcn_mfma_f32_32x32x16_bf16(pa3, ATT_PK2(1, 3), o[d0], 0, 0, 0);
        }
        SBAR();
    }
#undef ATT_RD
#undef ATT_PK2
}
struct VFrag { s16x4 lo[2][4], hi[2][4]; };
#define ATT_RDF(F, S, D) do { _Pragma("unroll") for (int ks = 0; ks < 4; ++ks) { \
        asm volatile("ds_read_b64_tr_b16 %0,%1 offset:%c2" : "=&v"(F.lo[S][ks]) : "v"(vb), "i"((D) * 4096 + ks * 1024) : "memory"); \
        asm volatile("ds_read_b64_tr_b16 %0,%1 offset:%c2" : "=&v"(F.hi[S][ks]) : "v"(vb), "i"((D) * 4096 + ks * 1024 + 512) : "memory"); } } while (0)
#define ATT_PKF(F, S, k) (bf16x8){F.lo[S][k][0], F.lo[S][k][1], F.lo[S][k][2], F.lo[S][k][3], F.hi[S][k][0], F.hi[S][k][1], F.hi[S][k][2], F.hi[S][k][3]}
__device__ __forceinline__ void pv4_issue0(VFrag& F, int vb) { ATT_RDF(F, 0, 0); }
__device__ __forceinline__ void pv4_rest(VFrag& F, f32x16* o, int vb, bf16x8 pa0, bf16x8 pa1, bf16x8 pa2, bf16x8 pa3) {
#pragma unroll
    for (int d0 = 0; d0 < 4; ++d0) {
        if (d0 + 1 < 4) { if ((d0 & 1) == 0) ATT_RDF(F, 1, d0 + 1); else ATT_RDF(F, 0, d0 + 1); asm volatile("s_waitcnt lgkmcnt(8)" ::: "memory"); }
        else asm volatile("s_waitcnt lgkmcnt(0)" ::: "memory");
        SBAR();
        if ((d0 & 1) == 0) {
            o[d0] = __builtin_amdgcn_mfma_f32_32x32x16_bf16(pa0, ATT_PKF(F, 0, 0), o[d0], 0, 0, 0); o[d0] = __builtin_amdgcn_mfma_f32_32x32x16_bf16(pa1, ATT_PKF(F, 0, 1), o[d0], 0, 0, 0);
            o[d0] = __builtin_amdgcn_mfma_f32_32x32x16_bf16(pa2, ATT_PKF(F, 0, 2), o[d0], 0, 0, 0); o[d0] = __builtin_amdgcn_mfma_f32_32x32x16_bf16(pa3, ATT_PKF(F, 0, 3), o[d0], 0, 0, 0);
        } else {
            o[d0] = __builtin_amdgcn_mfma_f32_32x32x16_bf16(pa0, ATT_PKF(F, 1, 0), o[d0], 0, 0, 0); o[d0] = __builtin_amdgcn_mfma_f32_32x32x16_bf16(pa1, ATT_PKF(F, 1, 1), o[d0], 0, 0, 0);
            o[d0] = __builtin_amdgcn_mfma_f32_32x32x16_bf16(pa2, ATT_PKF(F, 1, 2), o[d0], 0, 0, 0); o[d0] = __builtin_amdgcn_mfma_f32_32x32x16_bf16(pa3, ATT_PKF(F, 1, 3), o[d0], 0, 0, 0);
        }
        SBAR();
    }
}
__device__ __forceinline__ void qkt_c(f32x16& p0, f32x16& p1, lds_cptr Kslot, const bf16x8* qr, const f32x16& negm, int r32, int hi) {
    lds_cptr kb = Kslot + hi * 1024 + r32 * 16;
#pragma unroll
    for (int d0 = 0; d0 < 4; ++d0) {
        const bf16x8 b0 = *(const ATT_LAS bf16x8*)(kb + d0 * 2048);
        const bf16x8 b1 = *(const ATT_LAS bf16x8*)(kb + d0 * 2048 + 512);
        if (d0 == 0) { p0 = __builtin_amdgcn_mfma_f32_32x32x16_bf16(b0, qr[0], negm, 0, 0, 0); p1 = __builtin_amdgcn_mfma_f32_32x32x16_bf16(b1, qr[0], negm, 0, 0, 0); }
        else { p0 = __builtin_amdgcn_mfma_f32_32x32x16_bf16(b0, qr[d0], p0, 0, 0, 0); p1 = __builtin_amdgcn_mfma_f32_32x32x16_bf16(b1, qr[d0], p1, 0, 0, 0); } }
}
__device__ __forceinline__ void kload8(bf16x8* kf, lds_cptr kp) {
#pragma unroll
    for (int d0 = 0; d0 < 4; ++d0) { kf[2 * d0] = *(const ATT_LAS bf16x8*)(kp + d0 * 2048); kf[2 * d0 + 1] = *(const ATT_LAS bf16x8*)(kp + d0 * 2048 + 512); }
}
__device__ __forceinline__ void qk_held(f32x16& p0, f32x16& p1, const bf16x8* kf, const bf16x8* qr) {
    const f32x16 z = {0.f,0.f,0.f,0.f,0.f,0.f,0.f,0.f,0.f,0.f,0.f,0.f,0.f,0.f,0.f,0.f};
    p0 = __builtin_amdgcn_mfma_f32_32x32x16_bf16(kf[0], qr[0], z, 0, 0, 0); p1 = __builtin_amdgcn_mfma_f32_32x32x16_bf16(kf[1], qr[0], z, 0, 0, 0);
#pragma unroll
    for (int d0 = 1; d0 < 4; ++d0) { p0 = __builtin_amdgcn_mfma_f32_32x32x16_bf16(kf[2 * d0], qr[d0], p0, 0, 0, 0); p1 = __builtin_amdgcn_mfma_f32_32x32x16_bf16(kf[2 * d0 + 1], qr[d0], p1, 0, 0, 0); }
}
__device__ __forceinline__ void glds16(const void* gsrc, unsigned lds_dst) { unsigned keep;
    asm volatile("s_mov_b32 %0, m0\n\ts_mov_b32 m0, %2\n\ts_nop 0\n\tglobal_load_lds_dwordx4 %1, off\n\ts_mov_b32 m0, %0" : "=&s"(keep) : "v"(gsrc), "s"(lds_dst) : "memory"); }
__device__ __forceinline__ void diff_unit(int b, int h, int qb, const bf16_t* QA, const bf16_t* KA, const bf16_t* VA, bf16_t* ATT, float lam, lds_ptr lds, unsigned lds0, const int tid) {
    const int lane = tid & 63, r32 = lane & 31, hi = lane >> 5; const int wid = __builtin_amdgcn_readfirstlane(tid >> 6);
    const int grp = wid >> 2;
    const size_t m0 = (size_t)b * NREAL + (size_t)qb * 256 + wid * 32; const size_t kv0 = (size_t)b * KVROWS;
    const int vlane = ((lane >> 4) & 1) * 32 + (lane & 3) * 8 + (4 * hi + ((lane & 15) >> 2)) * 64;
    ATT_LAS float* wsf = (ATT_LAS float*)(lds + 131072 + wid * 256); const ATT_LAS float* wsh = wsf + 4 * hi;
#pragma unroll 1
    for (int c = 0; c < 2; ++c) {
        const int ch = h * 2 + c;
        bf16x8 qr[4];
#pragma unroll
        for (int d0 = 0; d0 < 4; ++d0) qr[d0] = *(const bf16x8*)(QA + m0 * 512 + ch * 64 + ((unsigned)r32 * 512u + (unsigned)hi * 8u + d0 * 16));
        const bf16_t* ksrc_u = KA + kv0 * 512 + ch * 64 + wid * 8; const unsigned koff = (unsigned)lane * 512u;
        const bf16_t* vsrc_u = VA + (kv0 + (wid & 3) * 16) * 512 + h * 128 + (wid >> 2) * 32; const unsigned voff = (unsigned)(lane >> 2) * 512u + (unsigned)(lane & 3) * 8u;
#define DMA_K(T) glds16(ksrc_u + koff + (size_t)(T) * 64 * 512, (unsigned)__builtin_amdgcn_readfirstlane(lds0 + (unsigned)(((T) & 3) * 8192 + wid * 1024)))
#define DMA_V(T) do { const bf16_t* vp_ = vsrc_u + voff + (size_t)(T) * 64 * 512; const unsigned vd_ = lds0 + (unsigned)(32768 + ((T) & 3) * 16384 + wid * 1024); \
            glds16(vp_, (unsigned)__builtin_amdgcn_readfirstlane(vd_)); glds16(vp_ + 64, (unsigned)__builtin_amdgcn_readfirstlane(vd_ + 8192u)); } while (0)
        DMA_K(0); DMA_V(0); DMA_K(1); DMA_V(1); DMA_K(2); DMA_V(2); DMA_K(3);
        asm volatile("s_waitcnt vmcnt(0) lgkmcnt(0)\n\ts_barrier" ::: "memory");
        f32x16 o[4];
#pragma unroll
        for (int d = 0; d < 4; ++d) o[d] = splat16(0.f);
        float mref = 0.f, l = 0.f; f32x16 negm = splat16(0.f); asm volatile("" : "+v"(negm));
        f32x16 p0, p1; u32x4 pw0 = {0u, 0u, 0u, 0u}, pw1 = pw0, pw2 = pw0, pw3 = pw0;
        qkt(p0, p1, (lds_cptr)lds, qr, r32, hi); asm volatile("s_nop 15\n\ts_nop 15" : "+v"(p0), "+v"(p1));
        { const float rm0 = rowmax_fast(p0, p1); mref = rm0;
#pragma unroll
          for (int r = 0; r < 16; ++r) { p0[r] -= rm0; p1[r] -= rm0; }
          negm = splat16(-mref); asm volatile("" : "+v"(negm)); }
#define DIFF_X(T, MASK) do { \
            if (MASK) { _Pragma("unroll") for (int r = 0; r < 16; ++r) { if (r >= 8) p0[r] = NEG_INF; p1[r] = NEG_INF; } } \
            const float rm = rowmax_fast(p0, p1); \
            if (__any(rm > 8.0f)) { const float dl = __builtin_fmaxf(rm, 0.f); mref += dl; \
                _Pragma("unroll") for (int r = 0; r < 16; ++r) { p0[r] -= dl; p1[r] -= dl; } \
                negm = splat16(-mref); asm volatile("" : "+v"(negm)); \
                const float f = __builtin_amdgcn_exp2f(-dl); l *= f; wsf[r32] = f; \
                _Pragma("unroll") for (int r = 0; r < 16; ++r) { const float fr_ = wsh[(r & 3) + 8 * (r >> 2)]; _Pragma("unroll") for (int d = 0; d < 4; ++d) o[d][r] *= fr_; } } \
            float s0 = 0.f, s1 = 0.f; \
            _Pragma("unroll") for (int r = 0; r < 16; ++r) { p0[r] = __builtin_amdgcn_exp2f(p0[r]); p1[r] = __builtin_amdgcn_exp2f(p1[r]); s0 += p0[r]; s1 += p1[r]; } \
            l += s0 + s1; \
            pw0 = (u32x4){cvtpk_s(p0[0], p0[1]), cvtpk_s(p0[2], p0[3]), cvtpk_s(p0[4], p0[5]), cvtpk_s(p0[6], p0[7])}; \
            pw1 = (u32x4){cvtpk_s(p0[8], p0[9]), cvtpk_s(p0[10], p0[11]), cvtpk_s(p0[12], p0[13]), cvtpk_s(p0[14], p0[15])}; \
            pw2 = (u32x4){cvtpk_s(p1[0], p1[1]), cvtpk_s(p1[2], p1[3]), cvtpk_s(p1[4], p1[5]), cvtpk_s(p1[6], p1[7])}; \
            pw3 = (u32x4){cvtpk_s(p1[8], p1[9]), cvtpk_s(p1[10], p1[11]), cvtpk_s(p1[12], p1[13]), cvtpk_s(p1[14], p1[15])}; } while (0)
#define DIFF_Y(T) do { VFrag vf_; const int vb_ = (int)(lds0 + 32768 + ((T) & 3) * 16384) + vlane; \
            pv4_issue0(vf_, vb_); \
            const bf16x8 pa0_ = __builtin_bit_cast(bf16x8, pw0), pa1_ = __builtin_bit_cast(bf16x8, pw1), pa2_ = __builtin_bit_cast(bf16x8, pw2), pa3_ = __builtin_bit_cast(bf16x8, pw3); \
            if ((T) + 1 < NKT) { qkt_c(p0, p1, (lds_cptr)(lds + (((T) + 1) & 3) * 8192), qr, negm, r32, hi); } \
            SBAR(); \
            pv4_rest(vf_, o, vb_, pa0_, pa1_, pa2_, pa3_); \
            asm volatile("s_nop 7" : "+v"(p0), "+v"(p1)); } while (0)
#define DIFF_STAGE(T) do { if ((T) + 4 < NKT) DMA_K((T) + 4); if ((T) + 3 < NKT) DMA_V((T) + 3); } while (0)
#define DIFF_BARV(T) do { if ((T) + 6 < NKT) asm volatile("s_waitcnt vmcnt(6) lgkmcnt(0)\n\ts_barrier" ::: "memory"); else asm volatile("s_waitcnt vmcnt(0) lgkmcnt(0)\n\ts_barrier" ::: "memory"); } while (0)
#define DIFF_PINX() do { asm volatile("" : "+v"(pw0), "+v"(pw1), "+v"(pw2), "+v"(pw3), "+v"(l)); __builtin_amdgcn_sched_barrier(0); } while (0)
#pragma unroll 1
        for (int t = 0; t < NKT - 1; ++t) {
            if (grp == 1) { DIFF_BARV(t); DIFF_STAGE(t); }
            DIFF_X(t, false);
            DIFF_PINX();
            if (grp == 0) { DIFF_BARV(t); DIFF_STAGE(t); }
            DIFF_Y(t);
        }
        {
            if (grp == 1) DIFF_BARV(NKT - 1);
            DIFF_X(NKT - 1, true);
            DIFF_PINX();
            if (grp == 0) DIFF_BARV(NKT - 1);
            DIFF_Y(NKT - 1);
        }
        asm volatile("s_waitcnt vmcnt(0) lgkmcnt(0)\n\ts_barrier" ::: "memory");
#undef DIFF_BARV
#undef DIFF_PINX
#undef DIFF_STAGE
#undef DIFF_X
#undef DIFF_Y
#undef DMA_K
#undef DMA_V
        const float lt = l + __shfl_xor(l, 32); const float il = 1.0f / lt;
        wsf[r32] = il;
        __hip_bfloat16* obase = (__hip_bfloat16*)ATT + (m0 + 4 * hi) * 1024 + h * 128 + r32; asm volatile("" : "+v"(obase));
        if (c == 0) {
#pragma unroll
            for (int r = 0; r < 16; ++r) { const float rl = wsh[(r & 3) + 8 * (r >> 2)]; __hip_bfloat16* orow = obase + (size_t)((r & 3) + 8 * (r >> 2)) * 1024;
#pragma unroll
                for (int d = 0; d < 4; ++d) orow[d * 32] = __float2bfloat16(o[d][r] * rl); }
        } else {
#pragma unroll
            for (int r = 0; r < 16; ++r) { const float rl = wsh[(r & 3) + 8 * (r >> 2)]; float q = 0.f; __hip_bfloat16* orow = obase + (size_t)((r & 3) + 8 * (r >> 2)) * 1024;
#pragma unroll
                for (int d = 0; d < 4; ++d) { const float a0 = __bfloat162float(orow[d * 32]); const float v = a0 - lam * (o[d][r] * rl); o[d][r] = v; q += v * v; }
                q += __shfl_xor(q, 1); q += __shfl_xor(q, 2); q += __shfl_xor(q, 4); q += __shfl_xor(q, 8); q += __shfl_xor(q, 16);
                const float rs = __builtin_amdgcn_rsqf(q * (1.0f / 128.0f) + 1e-6f);
#pragma unroll
                for (int d = 0; d < 4; ++d) orow[d * 32] = __float2bfloat16(o[d][r] * rs); }
        }
    }
}

__device__ __forceinline__ void win_unit(int b, int qb, const bf16_t* QBW, const bf16_t* KB, const bf16_t* VB, bf16_t* ATT, const float* sink, lds_ptr lds, unsigned lds0, const int tid) {
    const int lane = tid & 63, r32 = lane & 31, hi = lane >> 5; const int wid = __builtin_amdgcn_readfirstlane(tid >> 6);
    const int hq = wid, hk = wid >> 2; const int q0 = qb * 32; const size_t m0 = (size_t)b * NREAL + q0; const size_t kv0 = (size_t)b * KVROWS;
    const int vlane = ((lane >> 4) & 1) * 32 + (lane & 3) * 8 + (4 * hi + ((lane & 15) >> 2)) * 64;
    ATT_LAS float* wsf = (ATT_LAS float*)(lds + 131072 + wid * 256); const ATT_LAS float* wsh = wsf + 4 * hi;
    bf16x8 qr[4];
#pragma unroll
    for (int d0 = 0; d0 < 4; ++d0) qr[d0] = *(const bf16x8*)(QBW + m0 * 512 + hq * 64 + ((unsigned)r32 * 512u + (unsigned)hi * 8u + d0 * 16));
    f32x16 o[2]; o[0] = splat16(0.f); o[1] = splat16(0.f);
    float mref = 0.f, l = (hi == 0) ? __builtin_amdgcn_exp2f(sink[hq] * 1.4426950408889634f) : 0.f;
    int jlo = (q0 - 128) >> 6; if (jlo < 0) jlo = 0; int jhi = (q0 + 31 + 128) >> 6; if (jhi > 127) jhi = 127; const int nt = jhi - jlo + 2;
    const bf16_t* ksrc_u = KB + kv0 * 128 + wid * 8; const unsigned koff = (unsigned)lane * 128u;
    const bf16_t* vsrc_u = VB + (kv0 + (wid & 3) * 16) * 128 + (wid >> 2) * 32; const unsigned voff = (unsigned)(lane >> 2) * 128u + (unsigned)(lane & 3) * 8u;
#define ksrc (ksrc_u + koff)
#define vsrc (vsrc_u + voff)
    u32x4 k0r, k1r, v0r, v1r;
    { const size_t adv = (size_t)jlo * 64 * 128; k0r = *(const u32x4*)(ksrc + adv); k1r = *(const u32x4*)(ksrc + adv + 64); v0r = *(const u32x4*)(vsrc + adv); v1r = *(const u32x4*)(vsrc + adv + 64); }
    *(ATT_LAS u32x4*)(lds + wid * 1024 + lane * 16) = k0r; *(ATT_LAS u32x4*)(lds + 8192 + wid * 1024 + lane * 16) = k1r;
    *(ATT_LAS u32x4*)(lds + 16384 + tid * 16) = v0r; *(ATT_LAS u32x4*)(lds + 24576 + tid * 16) = v1r;
    __syncthreads();
#pragma unroll 1
    for (int i = 0; i < nt; ++i) {
        const int j = (i < nt - 1) ? jlo + i : 128; const int buf = i & 1;
        if (i + 1 < nt) { const int jn = (i + 1 < nt - 1) ? jlo + i + 1 : 128; const size_t adv = (size_t)jn * 64 * 128;
            k0r = *(const u32x4*)(ksrc + adv); k1r = *(const u32x4*)(ksrc + adv + 64); v0r = *(const u32x4*)(vsrc + adv); v1r = *(const u32x4*)(vsrc + adv + 64); }
        { f32x16 p0, p1;
            qkt(p0, p1, (lds_cptr)(lds + buf * 32768 + hk * 8192), qr, r32, hi); asm volatile("s_nop 15\n\ts_nop 15" : "+v"(p0), "+v"(p1));
            if (j == 128) {
#pragma unroll
                for (int r = 0; r < 16; ++r) { if (r >= 8) p0[r] = NEG_INF; p1[r] = NEG_INF; }
            } else if (!(64 * j + 63 <= q0 + 128 && 64 * j >= q0 - 97)) { const int dq = 64 * j - (q0 + r32);
#pragma unroll
                for (int r = 0; r < 16; ++r) { const int d0_ = dq + crow(r, hi), d1_ = d0_ + 32;
                    if (d0_ > 128 || d0_ < -128) p0[r] = NEG_INF; if (d1_ > 128 || d1_ < -128) p1[r] = NEG_INF; } }
            softmax_pv<2>(p0, p1, mref, l, o, (int)(lds0 + buf * 32768 + 16384 + hk * 8192) + vlane, r32, wsf, wsh);
        }
        if (i + 1 < nt) { const int nb = buf ^ 1;
            *(ATT_LAS u32x4*)(lds + nb * 32768 + wid * 1024 + lane * 16) = k0r; *(ATT_LAS u32x4*)(lds + nb * 32768 + 8192 + wid * 1024 + lane * 16) = k1r;
            *(ATT_LAS u32x4*)(lds + nb * 32768 + 16384 + tid * 16) = v0r; *(ATT_LAS u32x4*)(lds + nb * 32768 + 24576 + tid * 16) = v1r; }
        __syncthreads();
    }
#undef ksrc
#undef vsrc
    ATT_LAS float* ssx = (ATT_LAS float*)(lds + 65536);
    { const float lt = l + __shfl_xor(l, 32); const float il = 1.0f / lt;
        wsf[r32] = il;
#pragma unroll
        for (int r = 0; r < 16; ++r) { const float rl = wsh[(r & 3) + 8 * (r >> 2)]; o[0][r] *= rl; o[1][r] *= rl;
            float q = o[0][r] * o[0][r] + o[1][r] * o[1][r];
            q += __shfl_xor(q, 1); q += __shfl_xor(q, 2); q += __shfl_xor(q, 4); q += __shfl_xor(q, 8); q += __shfl_xor(q, 16);
            if (r32 == 0) ssx[wid * 32 + crow(r, hi)] = q; } }
    __syncthreads();
    __hip_bfloat16* wbase = (__hip_bfloat16*)ATT + (m0 + 4 * hi) * 1024 + 512 + hq * 64 + r32; asm volatile("" : "+v"(wbase));
#pragma unroll
    for (int r = 0; r < 16; ++r) { const int rr = crow(r, hi); float tot = 0.f;
#pragma unroll
        for (int w = 0; w < 8; ++w) tot += ssx[w * 32 + rr];
        const float rs = __builtin_amdgcn_rsqf(tot * (1.0f / 512.0f) + 1e-6f);
        __hip_bfloat16* orow = wbase + (size_t)((r & 3) + 8 * (r >> 2)) * 1024;
        orow[0] = __float2bfloat16(o[0][r] * rs); orow[32] = __float2bfloat16(o[1][r] * rs); }
    __syncthreads();
}
#undef SBAR
}
constexpr int NWAVES = 8;
constexpr int BATCH = 4, SEQ = 8192, DM = 1024, NMETA = 16, DFF = 2816, INW = 2304, LTOT = SEQ + NMETA;
constexpr int M = BATCH * SEQ;
constexpr int KVROWS = att::KVROWS;
constexpr size_t MiB = 1u << 20;
constexpr size_t WS_SS = 0;
constexpr size_t WS_SSM = 4 * (size_t)M * 4;
constexpr size_t WS_META = 1 * MiB;
constexpr size_t WS_ROPE = 2 * MiB;
constexpr size_t WS_WGU1 = 5 * MiB, WS_WD1 = 16 * MiB, WS_WIN = 22 * MiB, WS_WOUT = 27 * MiB, WS_WGU2 = 29 * MiB, WS_WD2 = 40 * MiB;
constexpr size_t WS_XB = 46 * MiB;
constexpr size_t WS_ATT = 110 * MiB;
constexpr size_t WS_HID = 174 * MiB;
constexpr size_t WS_QA = 174 * MiB, WS_QB = 206 * MiB, WS_KA = 238 * MiB, WS_VA = 271 * MiB, WS_KB = 304 * MiB, WS_VB = 313 * MiB;
constexpr size_t WS_END = 350 * MiB;
static_assert(WS_KA + (size_t)BATCH * KVROWS * 512 * 2 <= WS_VA && WS_VA + (size_t)BATCH * KVROWS * 512 * 2 <= WS_KB && WS_KB + (size_t)BATCH * KVROWS * 128 * 2 <= WS_VB && WS_VB + (size_t)BATCH * KVROWS * 128 * 2 <= WS_END, "qkv map");
static_assert(WS_HID + (size_t)M * DFF * 2 <= WS_END && (size_t)LTOT * 64 * 4 <= 3 * MiB && WS_SSM + 256 <= WS_META, "ws map");
constexpr int LDS_BYTES = 147456;
#define LAS __attribute__((address_space(3)))
typedef unsigned short bf16;
typedef unsigned v4u __attribute__((ext_vector_type(4)));
typedef float f32x4 __attribute__((ext_vector_type(4)));
typedef short bf16x8 __attribute__((ext_vector_type(8)));
__device__ __forceinline__ unsigned f2bf(float f) { unsigned u = __builtin_bit_cast(unsigned, f); return (u + 0x7fffu + ((u >> 16) & 1u)) >> 16; }
__device__ __forceinline__ unsigned pk2(float lo, float hi) { return f2bf(lo) | (f2bf(hi) << 16); }
__device__ __forceinline__ float wave_sum(float v) {
#pragma unroll
    for (int o = 1; o < 64; o <<= 1) v += __shfl_xor(v, o);
    return v;
}
template <int RM> __device__ __forceinline__ int map_row(int n) {
    if (RM == 1) return (n >> 7) * 256 + (n & 127);
    if (RM == 2) return (n >> 7) * 256 + 128 + (n & 127);
    if (RM == 3) { const int t = n >> 8, r = n & 255, hl = r >> 6, e = r & 63; return t * 256 + (e >> 5) * 128 + hl * 32 + (e & 31); }
    return n;
}
template <int RM, int GM> __device__ __forceinline__ void p0_transpose_item(const float* W, int K, int N, bf16* WT, const float* g, const float* g2, LAS float* scr, int item, int lane) {
    const int nblk = N / 32, kb = item / nblk, nb = item % nblk, k0 = 64 * kb, n0 = 32 * nb;
    float wv[32];
#pragma unroll
    for (int i = 0; i < 32; ++i) wv[i] = __builtin_nontemporal_load(W + (size_t)(k0 + 2 * i + (lane >> 5)) * N + n0 + (lane & 31));
    float gv0 = 1.f, gv1 = 1.f;
    if (GM == 1) gv0 = g[k0 + lane];
    if (GM == 2) { const int k = k0 + lane; gv0 = (k < 512) ? g[k & 127] * 0.8f : g2[k - 512]; }
    (void)gv1;
#pragma unroll
    for (int i = 0; i < 32; ++i) { const int kk = 2 * i + (lane >> 5); const float gv = (GM == 0) ? 1.f : __shfl(gv0, kk);
        scr[kk * 33 + (lane & 31)] = wv[i] * gv; }
    asm volatile("s_waitcnt lgkmcnt(0)" ::: "memory");
    const int c = lane & 7;
#pragma unroll
    for (int j = 0; j < 4; ++j) { const int n = (lane >> 3) + 8 * j; const LAS float* s = scr + (8 * c) * 33 + n;
        v4u o; o.x = pk2(s[0 * 33], s[1 * 33]); o.y = pk2(s[2 * 33], s[3 * 33]); o.z = pk2(s[4 * 33], s[5 * 33]); o.w = pk2(s[6 * 33], s[7 * 33]);
        *(v4u*)(WT + (size_t)map_row<RM>(n0 + n) * K + k0 + 8 * c) = o; }
    asm volatile("s_waitcnt lgkmcnt(0)" ::: "memory");
}
__device__ __forceinline__ void row_to_bf16_ss(const float* xrow, bf16* orow, float* ssp, int lane) {
    const f32x4* xr = (const f32x4*)xrow + lane; f32x4 v[4]; float s = 0.f;
#pragma unroll
    for (int j = 0; j < 4; ++j) { v[j] = xr[64 * j]; s += (v[j].x * v[j].x + v[j].y * v[j].y) + (v[j].z * v[j].z + v[j].w * v[j].w); }
    s = wave_sum(s);
    unsigned long long* o8 = (unsigned long long*)orow + lane;
#pragma unroll
    for (int j = 0; j < 4; ++j) o8[64 * j] = (unsigned long long)pk2(v[j].x, v[j].y) | ((unsigned long long)pk2(v[j].z, v[j].w) << 32);
    if (lane == 0) *ssp = s;
}
__device__ __forceinline__ void meta_mma2(const bf16* A, const bf16* Bt0, const bf16* Bt1, int K, f32x4& c0, f32x4& c1, int lane) {
    const int fr = lane & 15, fq = lane >> 4; c0 = (f32x4){0.f, 0.f, 0.f, 0.f}; c1 = c0;
    const bf16* ap = A + (size_t)fr * K + 8 * fq; const bf16* b0p = Bt0 + (size_t)fr * K + 8 * fq; const bf16* b1p = Bt1 + (size_t)fr * K + 8 * fq;
#pragma unroll 4
    for (int k0 = 0; k0 < K; k0 += 32) { const bf16x8 a = *(const bf16x8*)(ap + k0), b0 = *(const bf16x8*)(b0p + k0), b1 = *(const bf16x8*)(b1p + k0);
        c0 = __builtin_amdgcn_mfma_f32_16x16x32_bf16(b0, a, c0, 0, 0, 0); c1 = __builtin_amdgcn_mfma_f32_16x16x32_bf16(b1, a, c1, 0, 0, 0); }
}

#define ss0 ((float*)(args.ws + WS_SS))
#define ss1 (ss0 + M)
#define ss2 (ss0 + 2 * M)
#define ss3 (ss0 + 3 * M)
#define ssm0 ((float*)(args.ws + WS_SSM))
#define ssm1 (ssm0 + 16)
#define metab ((bf16*)(args.ws + WS_META))
#define hidm (metab + 16 * 1024)
#define h1mb (hidm + 16 * DFF)
#define rope ((float*)(args.ws + WS_ROPE))
#define WGU1 ((bf16*)(args.ws + WS_WGU1))
#define WD1 ((bf16*)(args.ws + WS_WD1))
#define WIN ((bf16*)(args.ws + WS_WIN))
#define WOUT ((bf16*)(args.ws + WS_WOUT))
#define WGU2 ((bf16*)(args.ws + WS_WGU2))
#define WD2 ((bf16*)(args.ws + WS_WD2))
#define XB ((bf16*)(args.ws + WS_XB))
#define ATT ((bf16*)(args.ws + WS_ATT))
#define HID ((bf16*)(args.ws + WS_HID))
#define QA ((bf16*)(args.ws + WS_QA))
#define QBW ((bf16*)(args.ws + WS_QB))
#define KA ((bf16*)(args.ws + WS_KA))
#define VA ((bf16*)(args.ws + WS_VA))
#define KB ((bf16*)(args.ws + WS_KB))
#define VB ((bf16*)(args.ws + WS_VB))
#define RLX_AGENT __ATOMIC_RELAXED, __HIP_MEMORY_SCOPE_AGENT
constexpr size_t WS_BAR = 1 * MiB + 512 * 1024;
constexpr int BAR_ZERO_BYTES = 16384;
constexpr int MISC_OFF = LDS_BYTES - 64;
#define XB_TMO      128
#define XB_XCNT(j)  (256  + 64 * (j))
#define XB_XSUB(j)  (1280 + 64 * (j))
#define XB_XGEN(j)  (2304 + 64 * (j))
#define XB_TOP      3328
#define XB_TOPGEN   3392
#define XCD_BAR_WORDS 3456
#define XB_SPIN_CAP (1u << 18)

__device__ __forceinline__ unsigned xb_ld(unsigned* p)              { return __hip_atomic_load(p, __ATOMIC_RELAXED, __HIP_MEMORY_SCOPE_AGENT); }
__device__ __forceinline__ unsigned xb_add(unsigned* p, unsigned v) { return __hip_atomic_fetch_add(p, v, __ATOMIC_RELAXED, __HIP_MEMORY_SCOPE_AGENT); }
__device__ __forceinline__ unsigned xb_xcc_id() { return (unsigned)__builtin_amdgcn_s_getreg((3 << 11) | 20) & 0xFu; }
#define XB_SPIN(cond, bar) do { unsigned _sp = 0; while (cond) { __builtin_amdgcn_s_sleep(1); \
    if ((++_sp & 255u) == 0u) { if (xb_ld(&(bar)[XB_TMO])) break; if (_sp > XB_SPIN_CAP) { atomicAdd(&(bar)[XB_TMO], 1u); break; } } } } while (0)

struct XcdBarrier {
    unsigned* bar; unsigned x;
    volatile LAS unsigned* st;
};

__device__ __forceinline__ XcdBarrier xcd_barrier_post(unsigned* bar, volatile LAS unsigned* st, bool leader) {
    XcdBarrier b; b.bar = bar; b.x = xb_xcc_id(); b.st = st;
    if (leader) (void)xb_add(&bar[XB_XCNT(b.x)], 1u);
    return b;
}
__device__ __forceinline__ void xcd_barrier_complete(unsigned* bar, unsigned x, unsigned& nloc, unsigned& nx) {
    const unsigned G = gridDim.x * gridDim.y * gridDim.z;
    unsigned sum, cnt, mine, sp = 0u;
    for (;;) {
        sum = 0u; cnt = 0u; mine = 0u;
#pragma unroll
        for (unsigned j = 0; j < 16; ++j) { const unsigned c = xb_ld(&bar[XB_XCNT(j)]); sum += c; cnt += (c > 0u) ? 1u : 0u; mine = (j == x) ? c : mine; }
        if (sum == G) break;
        __builtin_amdgcn_s_sleep(1);
        if ((++sp & 255u) == 0u) { if (xb_ld(&bar[XB_TMO])) break; if (sp > XB_SPIN_CAP) { atomicAdd(&bar[XB_TMO], 1u); break; } }
    }
    nloc = mine > 0u ? mine : 1u; nx = cnt > 0u ? cnt : 1u;
}

__device__ __forceinline__ void xcd_barrier(const XcdBarrier& b, bool leader) {
    asm volatile("s_waitcnt vmcnt(0)" ::: "memory");
    __syncthreads();
    if (leader) {
        unsigned* bar = b.bar;
        __builtin_amdgcn_s_waitcnt(0);
        unsigned nloc = b.st[0], nx = b.st[1];
        if (nloc == 0u) { xcd_barrier_complete(bar, b.x, nloc, nx); b.st[0] = nloc; b.st[1] = nx; }
        const unsigned old = xb_add(&bar[XB_XSUB(b.x)], 1u);
        const unsigned gen = old / nloc;
        if (old + 1u == (gen + 1u) * nloc) {
            __builtin_amdgcn_fence(__ATOMIC_RELEASE, "agent");
            asm volatile("s_waitcnt vmcnt(0)" ::: "memory");
            const unsigned og = xb_add(&bar[XB_TOP], 1u);
            const unsigned tg = og / nx;
            if (og + 1u == (tg + 1u) * nx) xb_add(&bar[XB_TOPGEN], 1u);
            else XB_SPIN(xb_ld(&bar[XB_TOPGEN]) == tg, bar);
            __builtin_amdgcn_fence(__ATOMIC_ACQUIRE, "agent");
            xb_add(&bar[XB_XGEN(b.x)], 1u);
            asm volatile("s_waitcnt vmcnt(0)" ::: "memory");
        } else {
            XB_SPIN(xb_ld(&bar[XB_XGEN(b.x)]) == gen, bar);
            __builtin_amdgcn_fence(__ATOMIC_ACQUIRE, "agent");
            asm volatile("s_waitcnt vmcnt(0)" ::: "memory");
        }
    }
    __syncthreads();
}

struct Args { const float* in[21]; float* out; unsigned char* ws; int ph_lo, ph_hi; };
constexpr int N_PHASES = 9;

__global__ void __launch_bounds__(NWAVES * 64, 2) hymba_fwd(Args args) {
    extern __shared__ __attribute__((aligned(16))) unsigned char lds[];
    __builtin_assume(__builtin_amdgcn_workitem_id_y() == 0); __builtin_assume(__builtin_amdgcn_workitem_id_z() == 0);
    LAS unsigned char* L = (LAS unsigned char*)lds;
    const int wave0 = __builtin_amdgcn_readfirstlane((int)threadIdx.x >> 6);
    const int G = gridDim.x; const int bx = blockIdx.x; const int vcu = (G % 8 == 0) ? (bx % 8) * (G / 8) + bx / 8 : bx;
    const int NGW = G * NWAVES, NGT = G * NWAVES * 64;
#define PHASE_IDS const int lane = (int)__builtin_amdgcn_mbcnt_hi(~0u, __builtin_amdgcn_mbcnt_lo(~0u, 0u)); const int wave = wave0; const int tid = wave * 64 + lane; \
    const int gw = vcu * NWAVES + wave; const int gtid = vcu * (NWAVES * 64) + tid; (void)lane; (void)gw; (void)gtid;
    const float* const x = args.in[0]; float* const out = args.out;
    const int lo = args.ph_lo, hi_ = args.ph_hi;
    XcdBarrier xbar; xbar.bar = (unsigned*)(args.ws + WS_BAR); xbar.x = 0; xbar.st = nullptr;
    const bool one_launch = (lo == 0 && hi_ == N_PHASES);
    if (one_launch) {
        const int lane0 = (int)__builtin_amdgcn_mbcnt_hi(~0u, __builtin_amdgcn_mbcnt_lo(~0u, 0u)); const bool leader0 = (wave0 == 0 && lane0 == 0);
        volatile LAS unsigned* st = (volatile LAS unsigned*)(L + MISC_OFF);
        if (leader0) { st[0] = 0u; st[1] = 0u; }
        __syncthreads();
        xbar = xcd_barrier_post((unsigned*)(args.ws + WS_BAR), st, leader0);
    }
#ifndef PHMASK
#define PHMASK 0x1ff
#endif
#define IN(k) (((PHMASK >> (k)) & 1) && lo <= (k) && (k) < hi_)
#define SEAM(k) do { if (IN(k) && IN((k) + 1)) { if (lo < 0) cg::this_grid().sync();     \
        const int lane_ = (int)__builtin_amdgcn_mbcnt_hi(~0u, __builtin_amdgcn_mbcnt_lo(~0u, 0u)); xcd_barrier(xbar, wave0 == 0 && lane_ == 0); } } while (0)

    if (IN(0)) { PHASE_IDS
        LAS float* scr = (LAS float*)(L + wave * 16384);
        constexpr int I_GU = (DM / 64) * (DFF / 32), I_DN = (DFF / 64) * (DM / 32), I_IN = (DM / 64) * (INW / 32), I_OUT = (DM / 64) * (DM / 32);
        constexpr int NITEMS = 4 * I_GU + 2 * I_DN + I_IN + I_OUT;
        for (int it = gw; it < NITEMS; it += NGW) {
            int r = it;
            if (r < I_GU) { p0_transpose_item<1, 1>(args.in[3], DM, DFF, WGU1, args.in[2], nullptr, scr, r, lane); continue; } r -= I_GU;
            if (r < I_GU) { p0_transpose_item<2, 1>(args.in[4], DM, DFF, WGU1, args.in[2], nullptr, scr, r, lane); continue; } r -= I_GU;
            if (r < I_GU) { p0_transpose_item<1, 1>(args.in[17], DM, DFF, WGU2, args.in[16], nullptr, scr, r, lane); continue; } r -= I_GU;
            if (r < I_GU) { p0_transpose_item<2, 1>(args.in[18], DM, DFF, WGU2, args.in[16], nullptr, scr, r, lane); continue; } r -= I_GU;
            if (r < I_DN) { p0_transpose_item<0, 0>(args.in[5], DFF, DM, WD1, nullptr, nullptr, scr, r, lane); continue; } r -= I_DN;
            if (r < I_DN) { p0_transpose_item<0, 0>(args.in[19], DFF, DM, WD2, nullptr, nullptr, scr, r, lane); continue; } r -= I_DN;
            if (r < I_IN) { p0_transpose_item<3, 1>(args.in[7], DM, INW, WIN, args.in[6], nullptr, scr, r, lane); continue; } r -= I_IN;
            p0_transpose_item<0, 2>(args.in[15], DM, DM, WOUT, args.in[12], args.in[14], scr, r, lane);
        }
        for (int m = gw; m < M; m += NGW) row_to_bf16_ss(x + (size_t)m * DM, XB + (size_t)m * DM, ss0 + m, lane);
        if (gw < 16) row_to_bf16_ss(args.in[1] + (size_t)gw * DM, metab + (size_t)gw * DM, ssm0 + gw, lane);
        for (int i = gtid; i < 3 * M; i += NGT) ss1[i] = 0.f;
        if (gtid < 16) ssm1[gtid] = 0.f;
        for (int i = gtid; i < LTOT * 32; i += NGT) { const int pos = i >> 5, k = i & 31;
            const float inv = exp2f(-(float)k * (13.287712379549449f / 32.0f)); const float ang = (float)pos * inv;
            rope[(size_t)pos * 64 + k] = cosf(ang); rope[(size_t)pos * 64 + 32 + k] = sinf(ang); }
    }
    SEAM(0);
    if (IN(1)) { PHASE_IDS
        if (gw < DFF / 16) { const int j = gw, t = j >> 3, within = (j & 7) * 16; const bf16* B0 = WGU1 + (size_t)(t * 256 + within) * DM; f32x4 c0, c1;
            meta_mma2(metab, B0, B0 + (size_t)128 * DM, DM, c0, c1, lane);
            const int fr = lane & 15, fq = lane >> 4; const float rs = pg8::rstd1024(ssm0[fr]);
#pragma unroll
            for (int e = 0; e < 4; ++e) hidm[(size_t)fr * DFF + j * 16 + 4 * fq + e] = (bf16)f2bf(pg8::silu_mul(c0[e] * rs, c1[e] * rs)); }
        pg8::Gemm g{XB, WGU1, M, 2 * DFF, DM}; pg8::StaticOrder S; S.init(M, 2 * DFF, G, bx);
        pg8::EpiSwiGLU E{HID, DFF, ss0};
        pg8::gemm_phase<pg8::EpiSwiGLU, pg8::StaticOrder, true, true>(L, g, S, E, tid);
    }
    SEAM(1);
    if (IN(2)) { PHASE_IDS
        if (gw < DM / 16) { const int n0 = gw * 16; f32x4 c0, c1; const bf16* B0 = WD1 + (size_t)n0 * DFF;
            meta_mma2(hidm, B0, B0, DFF, c0, c1, lane);
            const int fr = lane & 15, fq = lane >> 4; float q = 0.f;
#pragma unroll
            for (int e = 0; e < 4; ++e) { const int n = n0 + 4 * fq + e; const float v = args.in[1][(size_t)fr * DM + n] + 0.5f * c0[e]; h1mb[(size_t)fr * DM + n] = (bf16)f2bf(v); q += v * v; }
            q += __shfl_xor(q, 16); q += __shfl_xor(q, 32);
            if (fq == 0) __hip_atomic_fetch_add(ssm1 + fr, q, __ATOMIC_RELAXED, __HIP_MEMORY_SCOPE_AGENT); }
        pg8::Gemm g{HID, WD1, M, DM, DFF}; pg8::StaticOrder S; S.init(M, DM, G, bx);
        pg8::EpiResid<true> E{x, out, XB, ss1, 0.5f, DM};
        pg8::gemm_phase<pg8::EpiResid<true>, pg8::StaticOrder, true, true>(L, g, S, E, tid);
    }
    SEAM(2);
    if (IN(3)) { PHASE_IDS
        if (gw < 40) { const int ti = gw >> 3, j = gw & 7, t = (ti < 4) ? ti + 2 : 8, hl = j >> 1, i0 = (j & 1) * 16; f32x4 c0, c1;
            const bf16* B0 = WIN + (size_t)(t * 256 + hl * 32 + i0) * DM; meta_mma2(h1mb, B0, B0 + (size_t)128 * DM, DM, c0, c1, lane);
            const int fr = lane & 15, fq = lane >> 4, i = i0 + 4 * fq; const float rs = pg8::rstd1024(ssm1[fr]);
            bf16* dst; int ld, col; bool do_rope;
            if (t < 4) { dst = KA; ld = 512; col = ((t - 2) * 4 + hl) * 64; do_rope = true; }
            else if (t < 6) { dst = VA; ld = 512; col = (t - 4) * 256 + hl * 64; do_rope = false; }
            else if (hl < 2) { dst = KB; ld = 128; col = hl * 64; do_rope = true; }
            else { dst = VB; ld = 128; col = (hl - 2) * 64; do_rope = false; }
            float x1[4], x2[4];
#pragma unroll
            for (int e = 0; e < 4; ++e) { x1[e] = c0[e] * rs; x2[e] = c1[e] * rs;
                if (do_rope) { const float cs = rope[(size_t)fr * 64 + i + e], sn = rope[(size_t)fr * 64 + 32 + i + e]; const float a = x1[e] * cs - x2[e] * sn, b_ = x2[e] * cs + x1[e] * sn; x1[e] = a; x2[e] = b_; } }
            const unsigned long long w1 = (unsigned long long)pk2(x1[0], x1[1]) | ((unsigned long long)pk2(x1[2], x1[3]) << 32), w2 = (unsigned long long)pk2(x2[0], x2[1]) | ((unsigned long long)pk2(x2[2], x2[3]) << 32);
            for (int b = 0; b < BATCH; ++b) { bf16* p = dst + ((size_t)b * KVROWS + SEQ + fr) * ld + col + i; *(unsigned long long*)p = w1; *(unsigned long long*)(p + 32) = w2; } }
        { constexpr int PA = BATCH * 48 * 512 / 8, PB = BATCH * 48 * 128 / 8;
            for (int i = gtid; i < 2 * PA + 2 * PB; i += NGT) { int r = i; bf16* base; int ld;
                if (r < PA) { base = KA; ld = 512; } else if ((r -= PA) < PA) { base = VA; ld = 512; } else if ((r -= PA) < PB) { base = KB; ld = 128; } else { r -= PB; base = VB; ld = 128; }
                const int per_row = ld / 8, rowi = r / per_row, cpiece = r % per_row, b = rowi / 48, pr = rowi % 48;
                *(v4u*)(base + ((size_t)b * KVROWS + LTOT + pr) * ld + cpiece * 8) = (v4u){0u, 0u, 0u, 0u}; } }
        pg8::Gemm g{XB, WIN, M, INW, DM}; pg8::StaticOrder S; S.init(M, INW, G, bx);
        pg8::EpiQKV E{QA, KA, VA, QBW, KB, VB, ss1, rope};
        pg8::gemm_phase<pg8::EpiQKV, pg8::StaticOrder, true, true>(L, g, S, E, tid);
    }
    SEAM(3);
    if (IN(4)) { PHASE_IDS
        float lam;
        { const float a = args.in[8][lane] * args.in[9][lane], b_ = args.in[10][lane] * args.in[11][lane]; lam = expf(wave_sum(a)) - expf(wave_sum(b_)) + 0.2f; }
        const unsigned lds0 = (unsigned)(uintptr_t)lds;
        const int NDU = BATCH * 4 * (SEQ / 256), NWU = BATCH * (SEQ / 32);
        { const int per = (NDU + G - 1) / G; for (int u = vcu * per; u < (vcu + 1) * per && u < NDU; ++u) { const int bh = u >> 5, qb = u & 31; att::diff_unit(bh >> 2, bh & 3, qb, QA, KA, VA, ATT, lam, (att::lds_ptr)L, lds0, tid); } }
        { const int per = (NWU + G - 1) / G; for (int u = vcu * per; u < (vcu + 1) * per && u < NWU; ++u) { att::win_unit(u >> 8, u & 255, QBW, KB, VB, ATT, args.in[13], (att::lds_ptr)L, lds0, tid); } }
    }
    SEAM(4);
    if (IN(5)) { PHASE_IDS
        pg8::Gemm g{ATT, WOUT, M, DM, DM}; pg8::StaticOrder S; S.init(M, DM, G, bx);
        pg8::EpiResid<true> E{out, out, XB, ss2, 1.0f, DM};
        pg8::gemm_phase<pg8::EpiResid<true>, pg8::StaticOrder, true, true>(L, g, S, E, tid);
    }
    SEAM(5);
    if (IN(6)) { PHASE_IDS
        pg8::Gemm g{XB, WGU2, M, 2 * DFF, DM}; pg8::StaticOrder S; S.init(M, 2 * DFF, G, bx);
        pg8::EpiSwiGLU E{HID, DFF, ss2};
        pg8::gemm_phase<pg8::EpiSwiGLU, pg8::StaticOrder, true, true>(L, g, S, E, tid);
    }
    SEAM(6);
    if (IN(7)) { PHASE_IDS
        pg8::Gemm g{HID, WD2, M, DM, DFF}; pg8::StaticOrder S; S.init(M, DM, G, bx);
        pg8::EpiResid<false> E{out, out, nullptr, ss3, 0.5f, DM};
        pg8::gemm_phase<pg8::EpiResid<false>, pg8::StaticOrder, true, true>(L, g, S, E, tid);
    }
    SEAM(7);
    if (IN(8)) { PHASE_IDS
        const f32x4* gn = (const f32x4*)args.in[20] + lane;
        f32x4 g4[4];
#pragma unroll
        for (int j = 0; j < 4; ++j) g4[j] = gn[64 * j];
        for (int m = gw; m < M; m += 2 * NGW) {
            const int m1 = (m + NGW < M) ? m + NGW : m; const float rs0 = pg8::rstd1024(ss3[m]), rs1 = pg8::rstd1024(ss3[m1]);
            f32x4* o0 = (f32x4*)(out + (size_t)m * DM) + lane; f32x4* o1 = (f32x4*)(out + (size_t)m1 * DM) + lane; f32x4 v0[4], v1[4];
#pragma unroll
            for (int j = 0; j < 4; ++j) { v0[j] = o0[64 * j]; v1[j] = o1[64 * j]; }
#pragma unroll
            for (int j = 0; j < 4; ++j) o0[64 * j] = v0[j] * rs0 * g4[j];
            if (m1 != m) {
#pragma unroll
                for (int j = 0; j < 4; ++j) o1[64 * j] = v1[j] * rs1 * g4[j]; } }
    }
#undef IN
#undef SEAM
}

extern "C" void kernel_launch(void* const* d_in, const int* in_sizes, int n_in, void* d_out, int out_size, void* d_ws, size_t ws_size, hipStream_t stream) {
    static int grid = 0;
    if (grid == 0) {
        if (n_in != 21 || out_size != M * DM || ws_size < WS_END) { fprintf(stderr, "kernel_launch: unexpected shapes (n_in %d out %d ws %zu)\n", n_in, out_size, ws_size); grid = -1; return; }
        int dev = 0, cus = 0, per_cu = 0;
        if (hipGetDevice(&dev) != hipSuccess || hipDeviceGetAttribute(&cus, hipDeviceAttributeMultiprocessorCount, dev) != hipSuccess) { grid = -1; return; }
        if (hipFuncSetAttribute((const void*)hymba_fwd, hipFuncAttributeMaxDynamicSharedMemorySize, LDS_BYTES) != hipSuccess) { fprintf(stderr, "kernel_launch: hipFuncSetAttribute failed\n"); grid = -1; return; }
        if (hipOccupancyMaxActiveBlocksPerMultiprocessor(&per_cu, (const void*)hymba_fwd, NWAVES * 64, LDS_BYTES) != hipSuccess || per_cu < 1) { fprintf(stderr, "kernel_launch: occupancy query says %d\n", per_cu); per_cu = 1; }
        (void)hipGetLastError();
        grid = cus;
    }
    if (grid < 0) return;
    Args a{};
    for (int i = 0; i < 21; ++i) a.in[i] = (const float*)d_in[i];
    a.out = (float*)d_out; a.ws = (unsigned char*)d_ws;
#if MK_ONE_LAUNCH
    a.ph_lo = 0; a.ph_hi = N_PHASES;
    if (hipMemsetAsync((char*)d_ws + WS_BAR, 0, BAR_ZERO_BYTES, stream) != hipSuccess) { fprintf(stderr, "kernel_launch: memset of the barrier words failed\n"); return; }
    void* kargs[] = {&a};
    hipError_t e = hipLaunchCooperativeKernel((const void*)hymba_fwd, dim3(grid), dim3(NWAVES * 64), kargs, LDS_BYTES, stream);
    if (e != hipSuccess) fprintf(stderr, "kernel_launch: cooperative launch failed: %s (grid %d)\n", hipGetErrorString(e), grid);
#else
    for (int p = 0; p < N_PHASES; ++p) { a.ph_lo = p; a.ph_hi = p + 1; hipLaunchKernelGGL(hymba_fwd, dim3(grid), dim3(NWAVES * 64), LDS_BYTES, stream, a); }
#endif
}
```
